# Optimizing an MI355X kernel written in HIP

```python
import jax
import jax.numpy as jnp
from jax import lax
import numpy as np

D_MODEL = 1024
BATCH = 16
SEQ = 256
DEPTH = 2
DEC_BATCH = 8
DEC_SEQ = 4096
PAST_LEN = 256

GRID_W = 64
ROPE_BASE = 10000.0
NORM_EPS = 1e-6
QBLOCK = 128
NEG_BIG = -1e30
MLA_HEADS = 8
MLA_NOPE = 64
MLA_ROPE = 32
MLA_QK = MLA_NOPE + MLA_ROPE
MLA_V = 64
MLA_Q_RANK = 256
MLA_KV_RANK = 128
MLA_SCALE = MLA_QK ** -0.5
ML_HEADS = 4
ML_DK = 64
ML_DV = 128
ML_CHUNK = 64
SW_HEADS = 8
SW_KV_HEADS = 2
SW_HD = 64
SW_WINDOW = 128
SW_BLOCK = 128
SW_SCALE = SW_HD ** -0.5
RW_HEADS = 8
RW_N = 64
RW_DIM = RW_HEADS * RW_N
RW_W_RANK = 64
RW_A_RANK = 64
RW_G_RANK = 128
RW_DECAY_SCALE = 0.6065306597126334
RW_GN_EPS = 64e-5
D_FF = 4 * D_MODEL
N_BRANCH = 4
N_MOD = 6
IN_WIDTHS = (
    MLA_Q_RANK, MLA_KV_RANK, MLA_ROPE,
    ML_HEADS * ML_DK, ML_HEADS * ML_DK, ML_HEADS * ML_DV,
    2 * ML_HEADS, 2 * ML_HEADS, ML_HEADS * ML_DV,
    SW_HEADS * SW_HD, SW_KV_HEADS * SW_HD, SW_KV_HEADS * SW_HD,
    RW_DIM, RW_DIM, RW_DIM, 2 * RW_W_RANK, 2 * RW_A_RANK, RW_G_RANK,
    N_BRANCH * D_MODEL,
)
D_IN = sum(IN_WIDTHS)

kernel_name = 'hybrid_diffusion_prefix_trunk_step'


def rmsnorm(x, g):
    xf = x.astype(jnp.float32)
    y = xf * lax.rsqrt(jnp.mean(xf * xf, -1, keepdims=True) + NORM_EPS)
    return (y * g.astype(jnp.float32)).astype(x.dtype)


def split_columns(u):
    offsets = []
    acc = 0
    for w_ in IN_WIDTHS[:-1]:
        acc += w_
        offsets.append(acc)
    return jnp.split(u, offsets, axis=-1)


def grid_positions(n_tokens):
    t = jnp.arange(n_tokens, dtype=jnp.int32)
    return (t // GRID_W).astype(jnp.float32), (t % GRID_W).astype(jnp.float32)


def axial_rope(x, pos_r, pos_c):
    R = x.shape[-1]
    q = R // 4
    inv = ROPE_BASE ** (-jnp.arange(q, dtype=jnp.float32) / q)
    ar = pos_r[:, None] * inv
    ac = pos_c[:, None] * inv
    ang = jnp.concatenate([ar, ar, ac, ac], -1)[:, None, :]
    xf = x.astype(jnp.float32)
    rot = jnp.concatenate([-xf[..., q:2 * q], xf[..., :q], -xf[..., 3 * q:], xf[..., 2 * q:3 * q]], -1)
    return (xf * jnp.cos(ang) + rot * jnp.sin(ang)).astype(x.dtype)


def dense_attention(q, k, v, sink, scale):
    B, Sq, H, dq = q.shape
    G = k.shape[2]
    rep = H // G
    dv = v.shape[-1]
    nb = Sq // QBLOCK
    qb = jnp.moveaxis(q.reshape(B, nb, QBLOCK, G, rep, dq), 1, 0)

    def one(qblk):
        s = jnp.einsum('bqgrd,bkgd->bgrqk', qblk, k).astype(jnp.float32) * scale
        if sink is not None:
            s_snk = jnp.broadcast_to(sink.astype(jnp.float32).reshape(1, G, rep, 1, 1), s.shape[:-1] + (1,))
            p = jax.nn.softmax(jnp.concatenate([s, s_snk], -1), -1)[..., :-1]
        else:
            p = jax.nn.softmax(s, -1)
        return jnp.einsum('bgrqk,bkgd->bqgrd', p.astype(v.dtype), v)

    o = lax.map(one, qb)
    return jnp.moveaxis(o, 0, 1).reshape(B, Sq, H, dv)


def window_attention(q, k, v, k_ctx, v_ctx, sink, scale):
    B, S, H, d = q.shape
    G = k.shape[2]
    rep = H // G
    C = k_ctx.shape[1]
    nb = S // SW_BLOCK
    pad = ((0, 0), (SW_BLOCK, SW_BLOCK), (0, 0), (0, 0))
    kp = jnp.pad(k, pad).reshape(B, nb + 2, SW_BLOCK, G, d)
    vp = jnp.pad(v, pad).reshape(B, nb + 2, SW_BLOCK, G, d)
    kwin = jnp.concatenate([kp[:, :-2], kp[:, 1:-1], kp[:, 2:]], axis=2)
    vwin = jnp.concatenate([vp[:, :-2], vp[:, 1:-1], vp[:, 2:]], axis=2)
    qi = jnp.arange(SW_BLOCK)
    kj = jnp.arange(3 * SW_BLOCK)
    rel = kj[None, :] - SW_BLOCK - qi[:, None]
    kpos = jnp.arange(nb)[:, None] * SW_BLOCK - SW_BLOCK + kj[None, :]
    mask = (jnp.abs(rel) <= SW_WINDOW)[None] & ((kpos >= 0) & (kpos < S))[:, None, :]
    qb = q.reshape(B, nb, SW_BLOCK, G, rep, d)
    sink_gr = sink.astype(jnp.float32).reshape(1, G, rep, 1, 1)
    n_loc = 3 * SW_BLOCK

    def one(args):
        qblk, kblk, vblk, mblk = args
        s_loc = jnp.einsum('bqgrd,bkgd->bgrqk', qblk, kblk).astype(jnp.float32) * scale
        s_loc = jnp.where(mblk, s_loc, NEG_BIG)
        s_ctx = jnp.einsum('bqgrd,bcgd->bgrqc', qblk, k_ctx).astype(jnp.float32) * scale
        s_snk = jnp.broadcast_to(sink_gr, s_loc.shape[:-1] + (1,))
        p = jax.nn.softmax(jnp.concatenate([s_loc, s_ctx, s_snk], -1), -1).astype(v.dtype)
        return (jnp.einsum('bgrqk,bkgd->bqgrd', p[..., :n_loc], vblk)
                + jnp.einsum('bgrqc,bcgd->bqgrd', p[..., n_loc:n_loc + C], v_ctx))

    o = lax.map(one, (jnp.moveaxis(qb, 1, 0), jnp.moveaxis(kwin, 1, 0), jnp.moveaxis(vwin, 1, 0), mask))
    return jnp.moveaxis(o, 0, 1).reshape(B, S, H, d)


def mla_keys_values(c_kv, k_rope, w_ukv, k_norm):
    B, S, _ = c_kv.shape
    kv = (c_kv @ w_ukv).reshape(B, S, MLA_HEADS, MLA_NOPE + MLA_V)
    k_nope, v = kv[..., :MLA_NOPE], kv[..., MLA_NOPE:]
    k = jnp.concatenate([k_nope, jnp.broadcast_to(k_rope[:, :, None, :], (B, S, MLA_HEADS, MLA_ROPE))], -1)
    return rmsnorm(k, k_norm), v


def rope_tail(x, pos):
    return jnp.concatenate([x[..., :MLA_NOPE], axial_rope(x[..., MLA_NOPE:], *pos)], -1)


def mlstm_scan(q, k, v, li, lf, C0, n0, m0):
    B, S, H, _ = q.shape
    L = ML_CHUNK
    nc = S // L

    def to_chunks(a):
        a = a.reshape((B, nc, L, H) + a.shape[3:])
        return jnp.moveaxis(a, (1, 3), (0, 2))

    causal = jnp.tril(jnp.ones((L, L), dtype=bool))

    def body(carry, inp):
        C, n, m = carry
        qc, kc, vc, ic, fc = inp
        b = jnp.cumsum(fc, -1)
        D = jnp.where(causal, b[..., :, None] - b[..., None, :] + ic[..., None, :], -jnp.inf)
        inter = b + m[..., None]
        m_t = jnp.maximum(inter, jnp.max(D, -1))
        W = jnp.einsum('bhtd,bhsd->bhts', qc, kc) * jnp.exp(D - m_t[..., None])
        a_in = jnp.exp(inter - m_t)
        num = jnp.einsum('bhts,bhsv->bhtv', W, vc) + a_in[..., None] * jnp.einsum('bhtd,bhdv->bhtv', qc, C)
        den = jnp.sum(W, -1) + a_in * jnp.einsum('bhtd,bhd->bht', qc, n)
        h = num / jnp.maximum(jnp.abs(den), jnp.exp(-m_t))[..., None]
        bL = b[..., -1]
        g = bL[..., None] - b + ic
        m_new = jnp.maximum(bL + m, jnp.max(g, -1))
        wk = jnp.exp(g - m_new[..., None])
        decay = jnp.exp(bL + m - m_new)
        C_new = decay[..., None, None] * C + jnp.einsum('bhs,bhsd,bhsv->bhdv', wk, kc, vc)
        n_new = decay[..., None] * n + jnp.einsum('bhs,bhsd->bhd', wk, kc)
        return (C_new, n_new, m_new), h

    (C, n, m), h = lax.scan(body, (C0, n0, m0), tuple(to_chunks(t) for t in (q, k, v, li, lf)))
    h = jnp.moveaxis(h, (0, 2), (1, 3)).reshape(B, S, H, v.shape[-1])
    return h, C, n, m


def rwkv7_scan(r, w, kt, v, kh, a, S0):
    xs = tuple(jnp.moveaxis(t, 1, 0) for t in (r, w, kt, v, kh, a))

    def step(Sm, inp):
        r_t, w_t, k_t, v_t, kh_t, a_t = inp
        sk = jnp.einsum('bhvk,bhk->bhv', Sm, kh_t)
        Sn = Sm * w_t[:, :, None, :] - sk[..., None] * (a_t * kh_t)[:, :, None, :] + v_t[..., None] * k_t[:, :, None, :]
        return Sn, jnp.einsum('bhvk,bhk->bhv', Sn, r_t)

    Sf, y = lax.scan(step, S0, xs)
    return jnp.moveaxis(y, 0, 1), Sf


def rwkv_mixer(r_r, r_k, r_v, r_w1, r_a1, r_g1, P, l, S0):
    B, S, _ = r_r.shape
    f32 = jnp.float32
    hv = lambda t: t.astype(f32).reshape(B, S, RW_HEADS, RW_N)
    r, k, v = hv(r_r), hv(r_k), hv(r_v)
    kappa = k * P['rwkv_kk'][l].astype(f32).reshape(RW_HEADS, RW_N)
    kh = kappa * lax.rsqrt(jnp.sum(kappa * kappa, -1, keepdims=True) + 1e-12)
    g = (jax.nn.sigmoid(r_g1) @ P['rwkv_g2'][l]).astype(f32)
    ka = P['rwkv_ka'][l].astype(f32).reshape(RW_HEADS, RW_N)
    ys, bonuses, states = [], [], []
    for d in range(2):
        w_pre = jnp.tanh(r_w1[..., d * RW_W_RANK:(d + 1) * RW_W_RANK]) @ P['rwkv_w2'][l, d] + P['rwkv_w0'][l, d]
        w = jnp.exp(-RW_DECAY_SCALE * jax.nn.sigmoid(w_pre.astype(f32))).reshape(B, S, RW_HEADS, RW_N)
        a_pre = r_a1[..., d * RW_A_RANK:(d + 1) * RW_A_RANK] @ P['rwkv_a2'][l, d] + P['rwkv_a0'][l, d]
        a = jax.nn.sigmoid(a_pre.astype(f32)).reshape(B, S, RW_HEADS, RW_N)
        kt = k * (1.0 + (a - 1.0) * ka)
        seqs = (r, w, kt, v, kh, a)
        if d == 1:
            seqs = tuple(jnp.flip(t, 1) for t in seqs)
        y_d, S_d = rwkv7_scan(*seqs, S0[:, d].astype(f32))
        if d == 1:
            y_d = jnp.flip(y_d, 1)
        ys.append(y_d)
        bonuses.append(jnp.sum(r * kt * P['rwkv_u'][l, d].astype(f32).reshape(RW_HEADS, RW_N), -1, keepdims=True) * v)
        states.append(S_d)
    y = ys[0] + ys[1]
    mu = jnp.mean(y, -1, keepdims=True)
    var = jnp.mean(jnp.square(y - mu), -1, keepdims=True)
    yn = (y - mu) * lax.rsqrt(var + RW_GN_EPS)
    yn = yn * P['rwkv_gn_g'][l].astype(f32).reshape(RW_HEADS, RW_N) + P['rwkv_gn_b'][l].astype(f32).reshape(RW_HEADS, RW_N)
    out = ((yn + bonuses[0] + bonuses[1]).reshape(B, S, RW_DIM) * g).astype(r_r.dtype)
    return out, jnp.stack(states, 1)


def token_mixers(h, P, l, ctx, pos):
    B, S, _ = h.shape
    f32 = jnp.float32
    (q_a, kv_a, k_rope, m_q, m_k, m_v, m_i, m_f, m_o,
     s_q, s_k, s_v, r_r, r_k, r_v, r_w1, r_a1, r_g1, gate_pre) = split_columns(h @ P['w_in'][l])

    c_kv = rmsnorm(kv_a, P['mla_kv_a_norm'][l])
    q_lat = rmsnorm(q_a, P['mla_q_a_norm'][l])
    q_mla = rmsnorm((q_lat @ P['mla_w_uq'][l]).reshape(B, S, MLA_HEADS, MLA_QK), P['mla_q_norm'][l])
    k_mla, v_mla = mla_keys_values(c_kv, k_rope, P['mla_w_ukv'][l], P['mla_k_norm'][l])
    if ctx is None:
        y_a = dense_attention(q_mla, k_mla, v_mla, None, MLA_SCALE)
    else:
        q_mla = rope_tail(q_mla, pos)
        k_mla = rope_tail(k_mla, pos)
        k_c, v_c = mla_keys_values(ctx['mla_ckv'], ctx['mla_krope'], P['mla_w_ukv'][l], P['mla_k_norm'][l])
        y_a = dense_attention(q_mla, jnp.concatenate([k_mla, k_c], 1), jnp.concatenate([v_mla, v_c], 1), None, MLA_SCALE)
    y_a = y_a.reshape(B, S, MLA_HEADS * MLA_V)

    mq = m_q.astype(f32).reshape(B, S, ML_HEADS, ML_DK) * (ML_DK ** -0.5)
    mk = m_k.astype(f32).reshape(B, S, ML_HEADS, ML_DK)
    mv = m_v.astype(f32).reshape(B, S, ML_HEADS, ML_DV)
    li = m_i.astype(f32).reshape(B, S, 2, ML_HEADS) + P['mlstm_i_bias'][l].astype(f32)
    lf = jax.nn.log_sigmoid(m_f.astype(f32).reshape(B, S, 2, ML_HEADS) + P['mlstm_f_bias'][l].astype(f32))
    if ctx is None:
        C0 = jnp.zeros((B, 2, ML_HEADS, ML_DK, ML_DV), f32)
        n0 = jnp.zeros((B, 2, ML_HEADS, ML_DK), f32)
        m0 = jnp.zeros((B, 2, ML_HEADS), f32)
    else:
        C0 = ctx['mlstm_C'].astype(f32)
        n0 = ctx['mlstm_n'].astype(f32)
        m0 = ctx['mlstm_m'].astype(f32)
    h_f, C_f, n_f, m_f_ = mlstm_scan(mq, mk, mv, li[:, :, 0], lf[:, :, 0], C0[:, 0], n0[:, 0], m0[:, 0])
    fl = lambda t: jnp.flip(t, 1)
    h_b, C_b, n_b, m_b = mlstm_scan(fl(mq), fl(mk), fl(mv), fl(li[:, :, 1]), fl(lf[:, :, 1]), C0[:, 1], n0[:, 1], m0[:, 1])
    h_ml = rmsnorm(h_f + fl(h_b), P['mlstm_norm'][l]) * jax.nn.sigmoid(m_o.astype(f32)).reshape(B, S, ML_HEADS, ML_DV)
    y_b = h_ml.reshape(B, S, ML_HEADS * ML_DV).astype(h.dtype)

    sq = rmsnorm(s_q.reshape(B, S, SW_HEADS, SW_HD), P['swa_q_norm'][l])
    sk = rmsnorm(s_k.reshape(B, S, SW_KV_HEADS, SW_HD), P['swa_k_norm'][l])
    sv = s_v.reshape(B, S, SW_KV_HEADS, SW_HD)
    if ctx is None:
        y_c = dense_attention(sq, sk, sv, P['swa_sink'][l], SW_SCALE)
    else:
        y_c = window_attention(axial_rope(sq, *pos), axial_rope(sk, *pos), sv,
                               ctx['swa_k'], ctx['swa_v'], P['swa_sink'][l], SW_SCALE)
    y_c = y_c.reshape(B, S, SW_HEADS * SW_HD)

    rw0 = None if ctx is None else ctx['rwkv']
    if rw0 is None:
        rw0 = jnp.zeros((B, 2, RW_HEADS, RW_N, RW_N), f32)
    y_d, S_rw = rwkv_mixer(r_r, r_k, r_v, r_w1, r_a1, r_g1, P, l, rw0)

    gates = jax.nn.sigmoid(gate_pre.astype(f32)).astype(h.dtype).reshape(B, S, N_BRANCH, D_MODEL)
    merged = (gates[:, :, 0] * (y_a @ P['mla_w_o'][l]) + gates[:, :, 1] * (y_b @ P['mlstm_w_o'][l])
              + gates[:, :, 2] * (y_c @ P['swa_w_o'][l]) + gates[:, :, 3] * (y_d @ P['rwkv_w_o'][l]))
    out = merged @ P['w_out'][l]
    new_ctx = {'mla_ckv': c_kv, 'mla_krope': k_rope, 'swa_k': sk, 'swa_v': sv,
               'mlstm_C': jnp.stack([C_f, C_b], 1), 'mlstm_n': jnp.stack([n_f, n_b], 1),
               'mlstm_m': jnp.stack([m_f_, m_b], 1), 'rwkv': S_rw}
    return out, new_ctx


def trunk_layer(x, mod, P, l, ctx, pos):
    shift1, scale1, gate1, shift2, scale2, gate2 = jnp.split(mod.astype(x.dtype), N_MOD, -1)
    h = rmsnorm(x, P['norm1'][l]) * (1.0 + scale1) + shift1
    mix, new_ctx = token_mixers(h, P, l, ctx, pos)
    x = x + gate1 * mix
    h = rmsnorm(x, P['norm2'][l]) * (1.0 + scale2) + shift2
    f = jnp.square(jax.nn.relu(h @ P['mlp_w1'][l])) @ P['mlp_w2'][l]
    return x + gate2 * f, new_ctx


def setup_inputs(seed: int = 0) -> dict:
    key = jax.random.key(seed)
    ks = iter(jax.random.split(key, 64))
    L = DEPTH

    def nrm(shape, scale=1.0):
        return jax.random.normal(next(ks), shape, jnp.float32) * scale

    def gain(shape):
        return 1.0 + nrm(shape, 0.02)

    return {
        'x_prompt': nrm((BATCH, SEQ, D_MODEL)),
        'x_sample': nrm((DEC_BATCH, DEC_SEQ, D_MODEL)),
        'c': nrm((DEC_BATCH, D_MODEL)),
        'cache_mla_ckv': nrm((DEC_BATCH, L, PAST_LEN, MLA_KV_RANK)),
        'cache_mla_krope': nrm((DEC_BATCH, L, PAST_LEN, MLA_ROPE)),
        'cache_swa_k': nrm((DEC_BATCH, L, PAST_LEN, SW_KV_HEADS, SW_HD)),
        'cache_swa_v': nrm((DEC_BATCH, L, PAST_LEN, SW_KV_HEADS, SW_HD)),
        'state_mlstm_C': nrm((DEC_BATCH, L, 2, ML_HEADS, ML_DK, ML_DV), 0.1),
        'state_mlstm_n': nrm((DEC_BATCH, L, 2, ML_HEADS, ML_DK), 0.1),
        'state_mlstm_m': nrm((DEC_BATCH, L, 2, ML_HEADS), 0.5),
        'state_rwkv': nrm((DEC_BATCH, L, 2, RW_HEADS, RW_N, RW_N), 0.1),
        'c_ctx': nrm((D_MODEL,)),
        'ada_w': nrm((L, D_MODEL, N_MOD * D_MODEL), 0.5 * D_MODEL ** -0.5),
        'ada_b': nrm((L, N_MOD * D_MODEL), 0.02),
        'norm1': gain((L, D_MODEL)),
        'norm2': gain((L, D_MODEL)),
        'w_in': nrm((L, D_MODEL, D_IN), D_MODEL ** -0.5),
        'mla_q_a_norm': gain((L, MLA_Q_RANK)),
        'mla_kv_a_norm': gain((L, MLA_KV_RANK)),
        'mla_w_uq': nrm((L, MLA_Q_RANK, MLA_HEADS * MLA_QK), MLA_Q_RANK ** -0.5),
        'mla_w_ukv': nrm((L, MLA_KV_RANK, MLA_HEADS * (MLA_NOPE + MLA_V)), MLA_KV_RANK ** -0.5),
        'mla_q_norm': gain((L, MLA_QK)),
        'mla_k_norm': gain((L, MLA_QK)),
        'mla_w_o': nrm((L, MLA_HEADS * MLA_V, D_MODEL), (MLA_HEADS * MLA_V) ** -0.5),
        'mlstm_i_bias': nrm((L, 2, ML_HEADS), 0.1),
        'mlstm_f_bias': jnp.linspace(3.0, 6.0, ML_HEADS)[None, None, :] + nrm((L, 2, ML_HEADS), 0.1),
        'mlstm_norm': gain((L, ML_DV)),
        'mlstm_w_o': nrm((L, ML_HEADS * ML_DV, D_MODEL), (ML_HEADS * ML_DV) ** -0.5),
        'swa_q_norm': gain((L, SW_HD)),
        'swa_k_norm': gain((L, SW_HD)),
        'swa_sink': nrm((L, SW_HEADS), 0.5),
        'swa_w_o': nrm((L, SW_HEADS * SW_HD, D_MODEL), (SW_HEADS * SW_HD) ** -0.5),
        'rwkv_w0': nrm((L, 2, RW_DIM), 0.5),
        'rwkv_w2': nrm((L, 2, RW_W_RANK, RW_DIM), 0.5 * RW_W_RANK ** -0.5),
        'rwkv_a0': nrm((L, 2, RW_DIM), 0.1),
        'rwkv_a2': nrm((L, 2, RW_A_RANK, RW_DIM), 0.5 * RW_A_RANK ** -0.5),
        'rwkv_g2': nrm((L, RW_G_RANK, RW_DIM), RW_G_RANK ** -0.5),
        'rwkv_kk': 0.85 + nrm((L, RW_DIM), 0.05),
        'rwkv_ka': 1.0 + nrm((L, RW_DIM), 0.05),
        'rwkv_u': nrm((L, 2, RW_DIM), 0.3),
        'rwkv_gn_g': gain((L, RW_DIM)),
        'rwkv_gn_b': nrm((L, RW_DIM), 0.02),
        'rwkv_w_o': nrm((L, RW_DIM, D_MODEL), RW_DIM ** -0.5),
        'w_out': nrm((L, D_MODEL, D_MODEL), D_MODEL ** -0.5),
        'mlp_w1': nrm((L, D_MODEL, D_FF), D_MODEL ** -0.5),
        'mlp_w2': nrm((L, D_FF, D_MODEL), D_FF ** -0.5),
    }


def reference(x_prompt, x_sample, c, cache_mla_ckv, cache_mla_krope, cache_swa_k, cache_swa_v,
              state_mlstm_C, state_mlstm_n, state_mlstm_m, state_rwkv,
              c_ctx, ada_w, ada_b, norm1, norm2, w_in,
              mla_q_a_norm, mla_kv_a_norm, mla_w_uq, mla_w_ukv, mla_q_norm, mla_k_norm, mla_w_o,
              mlstm_i_bias, mlstm_f_bias, mlstm_norm, mlstm_w_o,
              swa_q_norm, swa_k_norm, swa_sink, swa_w_o,
              rwkv_w0, rwkv_w2, rwkv_a0, rwkv_a2, rwkv_g2, rwkv_kk, rwkv_ka, rwkv_u, rwkv_gn_g, rwkv_gn_b, rwkv_w_o,
              w_out, mlp_w1, mlp_w2):
    P = {'norm1': norm1, 'norm2': norm2, 'w_in': w_in,
         'mla_q_a_norm': mla_q_a_norm, 'mla_kv_a_norm': mla_kv_a_norm, 'mla_w_uq': mla_w_uq,
         'mla_w_ukv': mla_w_ukv, 'mla_q_norm': mla_q_norm, 'mla_k_norm': mla_k_norm, 'mla_w_o': mla_w_o,
         'mlstm_i_bias': mlstm_i_bias, 'mlstm_f_bias': mlstm_f_bias, 'mlstm_norm': mlstm_norm, 'mlstm_w_o': mlstm_w_o,
         'swa_q_norm': swa_q_norm, 'swa_k_norm': swa_k_norm, 'swa_sink': swa_sink, 'swa_w_o': swa_w_o,
         'rwkv_w0': rwkv_w0, 'rwkv_w2': rwkv_w2, 'rwkv_a0': rwkv_a0, 'rwkv_a2': rwkv_a2, 'rwkv_g2': rwkv_g2,
         'rwkv_kk': rwkv_kk, 'rwkv_ka': rwkv_ka, 'rwkv_u': rwkv_u, 'rwkv_gn_g': rwkv_gn_g, 'rwkv_gn_b': rwkv_gn_b,
         'rwkv_w_o': rwkv_w_o, 'w_out': w_out, 'mlp_w1': mlp_w1, 'mlp_w2': mlp_w2}

    x = x_prompt
    states = []
    for l in range(DEPTH):
        mod = (jax.nn.silu(c_ctx) @ ada_w[l] + ada_b[l])[None, None, :]
        x, st = trunk_layer(x, mod, P, l, None, None)
        states.append(st)
    y_prompt = x
    new_mla_ckv = jnp.stack([s['mla_ckv'] for s in states], 1)
    new_mla_krope = jnp.stack([s['mla_krope'] for s in states], 1)
    new_swa_k = jnp.stack([s['swa_k'] for s in states], 1)
    new_swa_v = jnp.stack([s['swa_v'] for s in states], 1)
    new_mlstm_C = jnp.stack([s['mlstm_C'] for s in states], 1)
    new_mlstm_n = jnp.stack([s['mlstm_n'] for s in states], 1)
    new_mlstm_m = jnp.stack([s['mlstm_m'] for s in states], 1)
    new_rwkv = jnp.stack([s['rwkv'] for s in states], 1)

    pos = grid_positions(x_sample.shape[1])
    x = x_sample
    for l in range(DEPTH):
        mod = (jax.nn.silu(c) @ ada_w[l] + ada_b[l])[:, None, :]
        ctx = {'mla_ckv': cache_mla_ckv[:, l], 'mla_krope': cache_mla_krope[:, l],
               'swa_k': cache_swa_k[:, l], 'swa_v': cache_swa_v[:, l],
               'mlstm_C': state_mlstm_C[:, l], 'mlstm_n': state_mlstm_n[:, l], 'mlstm_m': state_mlstm_m[:, l],
               'rwkv': state_rwkv[:, l]}
        x, _ = trunk_layer(x, mod, P, l, ctx, pos)
    y_sample = x
    return (y_prompt, y_sample, new_mla_ckv, new_mla_krope, new_swa_k, new_swa_v,
            new_mlstm_C, new_mlstm_n, new_mlstm_m, new_rwkv)
```

```cpp
#include <hip/hip_runtime.h>
#include <hip/hip_bf16.h>
#include <hip/hip_cooperative_groups.h>
#include <cstdio>
namespace cg = cooperative_groups;

#ifndef MEGA
#define MEGA 1
#endif

typedef unsigned short bf16_t;
typedef short bf16x8 __attribute__((ext_vector_type(8)));
typedef float f32x4 __attribute__((ext_vector_type(4)));
typedef unsigned u32x4 __attribute__((ext_vector_type(4)));
#define DEVI __device__ __forceinline__

constexpr int DIN = 8752;
constexpr int NTHREADS = 256;
constexpr int SMEM_BYTES = 80000;

constexpr size_t WT_LAYER = 21102592;
constexpr size_t W_IN = 0, W_UQ = 9043968, W_UKV = 9240576, W_OA = 9371648, W_OB = 9895936, W_OC = 10420224, W_OD = 10944512;
constexpr size_t W_W2 = 11468800  , W_A2 = 11534336  , W_G2 = 11599872, W_OUT = 11665408, W_M1 = 12713984, W_M2 = 16908288;

constexpr size_t OFF_WT = 0;
constexpr size_t OFF_MOD = 84410368;
constexpr size_t OFF_CTR = OFF_MOD + 442368;
constexpr size_t OFF_H = OFF_CTR + 256;
constexpr size_t OFF_U = OFF_H + 16777216;
constexpr size_t OFF_LIF = OFF_U + 143392768;
constexpr size_t OFF_CKV = OFF_LIF + 524288;
constexpr size_t OFF_KROPE = OFF_CKV + 2228224;
constexpr size_t OFF_Q = OFF_KROPE + 1114112;
constexpr size_t OFF_KNOPE = OFF_Q + 12582912;
constexpr size_t OFF_K = OFF_KNOPE + 8912896;
constexpr size_t OFF_VT = OFF_K + 13369344;
constexpr size_t OFF_QS = OFF_VT + 8912896;
constexpr size_t OFF_KS = OFF_QS + 8388608;
constexpr size_t OFF_VTS = OFF_KS + 2228224;
constexpr size_t OFF_WA = OFF_VTS + 2228224;
constexpr size_t OFF_G = OFF_WA + 33554432;
constexpr size_t OFF_YRW = OFF_G + 8388608;
constexpr size_t OFF_HML = OFF_YRW + 33554432;
constexpr size_t OFF_Y = OFF_HML + 33554432;
constexpr size_t OFF_MERGED = OFF_Y + 33554432;
constexpr size_t OFF_CTR2 = OFF_MERGED + 16777216;
constexpr size_t OFF_BAR = OFF_CTR2 + 4096;
constexpr size_t WS_TOTAL = OFF_BAR + 16384;

constexpr size_t O_YP = 0, O_YS = 4194304, O_CKV = 37748736, O_KROPE = 38797312, O_SWAK = 39059456, O_SWAV = 40108032;
constexpr size_t O_MLC = 41156608, O_MLN = 43253760, O_MLM = 43270144, O_RW = 43270400;

struct Params {
  const float* in[46];
  float* out;
  char* ws;
};

struct Grp { int tok0, NS, S, CTX, sample, batch0, TG, KS, NK; };
DEVI Grp get_grp(int g) {
  Grp G;
  if (g == 0) { G.tok0 = 0; G.NS = 16; G.S = 256; G.CTX = 0; G.sample = 0; G.batch0 = 0; G.TG = 4096; G.KS = 256; G.NK = 4096; }
  else { G.tok0 = 4096 + (g - 1) * 8192; G.NS = 2; G.S = 4096; G.CTX = 256; G.sample = 1; G.batch0 = (g - 1) * 2; G.TG = 8192; G.KS = 4352; G.NK = 8704; }
  return G;
}

DEVI bf16_t f2bf(float f) { unsigned u = __float_as_uint(f); u += 0x7fffu + ((u >> 16) & 1u); return (bf16_t)(u >> 16); }
DEVI float bf2f(bf16_t h) { return __uint_as_float(((unsigned)h) << 16); }
DEVI unsigned pack2(float a, float b) { unsigned r; asm("s_nop 1\n\tv_cvt_pk_bf16_f32 %0, %1, %2" : "=v"(r) : "v"(a), "v"(b)); return r; }
DEVI uint2 pack4(float a, float b, float c, float d) { uint2 r; r.x = pack2(a, b); r.y = pack2(c, d); return r; }
DEVI float lo16(unsigned u) { return __uint_as_float(u << 16); }
DEVI float hi16(unsigned u) { return __uint_as_float(u & 0xffff0000u); }
DEVI int opaque(int x) { asm volatile("" : "+v"(x)); return x; }
#define TIDX (opaque((int)__builtin_amdgcn_workitem_id_x()))
DEVI float sigm(float x) { return __builtin_amdgcn_rcpf(1.f + __expf(-x)); }
DEVI float wave_sum(float v) {
#pragma unroll
  for (int o = 32; o > 0; o >>= 1) v += __shfl_xor(v, o);
  return v;
}
template <int CTRL> DEVI float dpp_add(float x) {
  return x + __builtin_bit_cast(float, __builtin_amdgcn_update_dpp(0, __builtin_bit_cast(int, x), CTRL, 0xf, 0xf, false));
}
DEVI float row16_sum(float x) {
  x = dpp_add<0xB1>(x); x = dpp_add<0x4E>(x); x = dpp_add<0x141>(x); x = dpp_add<0x128>(x);
  return x;
}
DEVI f32x4 mma(bf16x8 arow, bf16x8 bcol, f32x4 c) { return __builtin_amdgcn_mfma_f32_16x16x32_bf16(bcol, arow, c, 0, 0, 0); }
DEVI bf16x8 ldfrag_l(const bf16_t* base, int stride, int row0, int k0, int lane) {
  return *(const bf16x8*)(base + (row0 + (lane & 15)) * stride + k0 + (lane >> 4) * 8);
}
DEVI bf16x8 ldfrag(const bf16_t* base, int stride, int row0, int k0) {
  int lane = TIDX & 63;
  return *(const bf16x8*)(base + (row0 + (lane & 15)) * stride + k0 + (lane >> 4) * 8);
}

DEVI void conv_T(const float* __restrict__ src, bf16_t* __restrict__ dst, int K, int N, int Npad, int& rot, int bid, int nblk, float* sm) {
  const int tid = TIDX;
  const int tk = K / 64, tn = Npad / 64, nt = tk * tn;
  int first = (bid + nblk - (rot % nblk)) % nblk;
  for (int t = first; t < nt; t += nblk) {
    int k0 = (t / tn) * 64, n0 = (t % tn) * 64;
    __syncthreads();
#pragma unroll 4
    for (int i = 0; i < 16; i++) {
      int r = i * 4 + (tid >> 6), c = tid & 63, n = n0 + c;
      sm[r * 65 + c] = (n < N) ? src[(size_t)(k0 + r) * N + n] : 0.f;
    }
    __syncthreads();
#pragma unroll 4
    for (int i = 0; i < 16; i++) {
      int r = i * 4 + (tid >> 6), c = tid & 63;
      dst[(size_t)(n0 + r) * K + k0 + c] = f2bf(sm[c * 65 + r]);
    }
  }
  rot += nt;
}

DEVI void phase_init(const Params& p, int bid, int nblk, char* smem) {
  const int tid = TIDX;
  if (bid == 0) for (int i = tid; i < 1024 + 4096; i += NTHREADS) ((int*)(p.ws + OFF_CTR2))[i] = 0;
  bf16_t* WT = (bf16_t*)(p.ws + OFF_WT);
  float* sm = (float*)smem;
  int rot = 0;
  for (int l = 0; l < 2; l++) {
    bf16_t* w = WT + (size_t)l * WT_LAYER;
    conv_T(p.in[16] + (size_t)l * 1024 * DIN, w + W_IN, 1024, DIN, 8832, rot, bid, nblk, sm);
    conv_T(p.in[44] + (size_t)l * 1024 * 4096, w + W_M1, 1024, 4096, 4096, rot, bid, nblk, sm);
    conv_T(p.in[45] + (size_t)l * 4096 * 1024, w + W_M2, 4096, 1024, 1024, rot, bid, nblk, sm);
    conv_T(p.in[43] + (size_t)l * 1024 * 1024, w + W_OUT, 1024, 1024, 1024, rot, bid, nblk, sm);
    conv_T(p.in[23] + (size_t)l * 512 * 1024, w + W_OA, 512, 1024, 1024, rot, bid, nblk, sm);
    conv_T(p.in[27] + (size_t)l * 512 * 1024, w + W_OB, 512, 1024, 1024, rot, bid, nblk, sm);
    conv_T(p.in[31] + (size_t)l * 512 * 1024, w + W_OC, 512, 1024, 1024, rot, bid, nblk, sm);
    conv_T(p.in[42] + (size_t)l * 512 * 1024, w + W_OD, 512, 1024, 1024, rot, bid, nblk, sm);
    conv_T(p.in[19] + (size_t)l * 256 * 768, w + W_UQ, 256, 768, 768, rot, bid, nblk, sm);
    conv_T(p.in[20] + (size_t)l * 128 * 1024, w + W_UKV, 128, 1024, 1024, rot, bid, nblk, sm);
    for (int d = 0; d < 2; d++) {
      conv_T(p.in[33] + (size_t)(l * 2 + d) * 64 * 512, w + W_W2 + d * 32768, 64, 512, 512, rot, bid, nblk, sm);
      conv_T(p.in[35] + (size_t)(l * 2 + d) * 64 * 512, w + W_A2 + d * 32768, 64, 512, 512, rot, bid, nblk, sm);
    }
    conv_T(p.in[36] + (size_t)l * 128 * 512, w + W_G2, 128, 512, 512, rot, bid, nblk, sm);
  }
  __syncthreads();
  float* sc = (float*)smem;
  float* red = sc + 9216;
  float* mod = (float*)(p.ws + OFF_MOD);
  bool any = false;
  for (int job = nblk - 1 - bid; job < 192; job += nblk) {
    if (!any) {
      for (int i = tid; i < 9216; i += NTHREADS) {
        int j = i >> 10, k = i & 1023;
        float c = (j == 0) ? p.in[11][k] : p.in[2][(j - 1) * 1024 + k];
        sc[i] = c / (1.f + __expf(-c));
      }
      any = true;
    }
    __syncthreads();
    int l = job / 96, n0 = (job % 96) * 64, kg = tid >> 6, cl = tid & 63, col = n0 + cl;
    float acc[9];
#pragma unroll
    for (int j = 0; j < 9; j++) acc[j] = 0.f;
    const float* w = p.in[12] + (size_t)l * 1024 * 6144 + col;
    for (int k = kg * 256; k < kg * 256 + 256; k++) {
      float wv = w[(size_t)k * 6144];
#pragma unroll
      for (int j = 0; j < 9; j++) acc[j] += sc[j * 1024 + k] * wv;
    }
#pragma unroll
    for (int j = 0; j < 9; j++) red[(kg * 9 + j) * 64 + cl] = acc[j];
    __syncthreads();
    if (kg == 0) {
      float bb = p.in[13][l * 6144 + col];
#pragma unroll
      for (int j = 0; j < 9; j++)
        mod[(size_t)(l * 9 + j) * 6144 + col] = red[j * 64 + cl] + red[(9 + j) * 64 + cl] + red[(18 + j) * 64 + cl] + red[(27 + j) * 64 + cl] + bb;
    }
  }
}

DEVI void phase_pre(const Params& p, int l, const Grp& G, int which, int bid, int nblk) {
  const float* nw = p.in[which ? 15 : 14] + l * 1024;
  const float* mod = (const float*)(p.ws + OFF_MOD);
  bf16_t* H = (bf16_t*)(p.ws + OFF_H);
  const int tid_ = TIDX, lane = tid_ & 63, wv = tid_ >> 6;
  const int stride = nblk * 4;
  for (int t0 = bid * 4 + wv; t0 < G.TG; t0 += 2 * stride) {
    const int t1 = t0 + stride;
    const bool has1 = t1 < G.TG;
    const float* x[2];
    int tt[2] = {t0, has1 ? t1 : t0};
#pragma unroll
    for (int u = 0; u < 2; u++) {
      int gt = G.tok0 + tt[u];
      if (which == 0 && l == 0) x[u] = (gt < 4096) ? p.in[0] + (size_t)gt * 1024 : p.in[1] + (size_t)(gt - 4096) * 1024;
      else x[u] = p.out + (size_t)gt * 1024;
    }
    float4 v[2][4];
#pragma unroll
    for (int u = 0; u < 2; u++)
#pragma unroll
      for (int i = 0; i < 4; i++) v[u][i] = *(const float4*)(x[u] + i * 256 + lane * 4);
#pragma unroll
    for (int u = 0; u < 2; u++) {
      if (u == 1 && !has1) break;
      const int t = tt[u];
      int j = G.sample ? 1 + G.batch0 + t / 4096 : 0;
      const float* md = mod + (size_t)(l * 9 + j) * 6144 + (which ? 3072 : 0);
      float ss = 0.f;
#pragma unroll
      for (int i = 0; i < 4; i++) ss += v[u][i].x * v[u][i].x + v[u][i].y * v[u][i].y + v[u][i].z * v[u][i].z + v[u][i].w * v[u][i].w;
      ss = wave_sum(ss);
      float rs = rsqrtf(ss * (1.f / 1024.f) + 1e-6f);
#pragma unroll
      for (int i = 0; i < 4; i++) {
        int c = i * 256 + lane * 4;
        float4 g = *(const float4*)(nw + c), sh = *(const float4*)(md + c), sc = *(const float4*)(md + 1024 + c);
        float o0 = v[u][i].x * rs * g.x * (1.f + sc.x) + sh.x;
        float o1 = v[u][i].y * rs * g.y * (1.f + sc.y) + sh.y;
        float o2 = v[u][i].z * rs * g.z * (1.f + sc.z) + sh.z;
        float o3 = v[u][i].w * rs * g.w * (1.f + sc.w) + sh.w;
        *(uint2*)(H + (size_t)t * 1024 + c) = pack4(o0, o1, o2, o3);
      }
    }
  }
}

DEVI void mfma_settle(f32x4 (&a)[4][4]) {
  asm volatile("s_nop 15\n\ts_nop 15\n\ts_nop 7"
               : "+v"(a[0][0]), "+v"(a[0][1]), "+v"(a[0][2]), "+v"(a[0][3]), "+v"(a[1][0]), "+v"(a[1][1]), "+v"(a[1][2]), "+v"(a[1][3]),
                 "+v"(a[2][0]), "+v"(a[2][1]), "+v"(a[2][2]), "+v"(a[2][3]), "+v"(a[3][0]), "+v"(a[3][1]), "+v"(a[3][2]), "+v"(a[3][3]));
}
DEVI void mfma_settle(f32x4 (&a)[4][2]) {
  asm volatile("s_nop 15\n\ts_nop 15\n\ts_nop 7"
               : "+v"(a[0][0]), "+v"(a[0][1]), "+v"(a[1][0]), "+v"(a[1][1]), "+v"(a[2][0]), "+v"(a[2][1]), "+v"(a[3][0]), "+v"(a[3][1]));
}
DEVI void mfma_settle9(f32x4 (&a)[9]) {
  asm volatile("s_nop 15\n\ts_nop 15\n\ts_nop 7"
               : "+v"(a[0]), "+v"(a[1]), "+v"(a[2]), "+v"(a[3]), "+v"(a[4]), "+v"(a[5]), "+v"(a[6]), "+v"(a[7]), "+v"(a[8]));
}

constexpr int LDT = 72;
template <int NJ>
DEVI void gemm_core(f32x4 (&acc)[4][NJ], const bf16_t* __restrict__ A, int lda, const bf16_t* __restrict__ B, int ldb, int K, char* smem) {
  constexpr int BUFE = 256 * LDT;
  bf16_t* sbase = (bf16_t*)smem;
  const int tid = TIDX, lane = tid & 63, wave = tid >> 6, wm = wave >> 1, wn = wave & 1;
  u32x4 ra[4], rb[NJ];
#pragma unroll
  for (int i = 0; i < 4; i++) {
    int id = tid + i * 256, r = id >> 3, ck = id & 7;
    ra[i] = *(const u32x4*)(A + (size_t)r * lda + ck * 8);
    if (i < NJ) rb[i] = *(const u32x4*)(B + (size_t)r * ldb + ck * 8);
  }
  __syncthreads();
#pragma unroll
  for (int i = 0; i < 4; i++) {
    int id = tid + i * 256, r = id >> 3, ck = id & 7;
    *(u32x4*)(sbase + r * LDT + ck * 8) = ra[i];
    if (i < NJ) *(u32x4*)(sbase + 128 * LDT + r * LDT + ck * 8) = rb[i];
  }
  if (64 < K) {
#pragma unroll
    for (int i = 0; i < 4; i++) {
      int id = tid + i * 256, r = id >> 3, ck = id & 7;
      ra[i] = *(const u32x4*)(A + (size_t)r * lda + 64 + ck * 8);
      if (i < NJ) rb[i] = *(const u32x4*)(B + (size_t)r * ldb + 64 + ck * 8);
    }
  }
  __syncthreads();
  int cur = 0;
#pragma unroll 2
  for (int k0 = 0; k0 < K; k0 += 64) {
    bf16_t* sA = sbase + cur * BUFE;
    bf16_t* sB = sA + 128 * LDT;
    if (k0 + 64 < K) {
      bf16_t* nA = sbase + (cur ^ 1) * BUFE;
      bf16_t* nB = nA + 128 * LDT;
#pragma unroll
      for (int i = 0; i < 4; i++) {
        int id = tid + i * 256, r = id >> 3, ck = id & 7;
        *(u32x4*)(nA + r * LDT + ck * 8) = ra[i];
        if (i < NJ) *(u32x4*)(nB + r * LDT + ck * 8) = rb[i];
      }
      if (k0 + 128 < K) {
#pragma unroll
        for (int i = 0; i < 4; i++) {
          int id = tid + i * 256, r = id >> 3, ck = id & 7;
          ra[i] = *(const u32x4*)(A + (size_t)r * lda + k0 + 128 + ck * 8);
          if (i < NJ) rb[i] = *(const u32x4*)(B + (size_t)r * ldb + k0 + 128 + ck * 8);
        }
      }
    }
#pragma unroll
    for (int kk = 0; kk < 2; kk++) {
      bf16x8 af[4], bf[NJ];
#pragma unroll
      for (int i = 0; i < 4; i++) af[i] = ldfrag_l(sA, LDT, wm * 64 + i * 16, kk * 32, lane);
#pragma unroll
      for (int j = 0; j < NJ; j++) bf[j] = ldfrag_l(sB, LDT, wn * NJ * 16 + j * 16, kk * 32, lane);
#pragma unroll
      for (int i = 0; i < 4; i++)
#pragma unroll
        for (int j = 0; j < NJ; j++) acc[i][j] = mma(af[i], bf[j], acc[i][j]);
    }
    __syncthreads();
    cur ^= 1;
  }
  mfma_settle(acc);
}

template <class Epi>
DEVI void gemm_tiles(const bf16_t* A, int lda, const bf16_t* B, int ldb, int M, int N, int K, int& rot, int bid, int nblk, char* smem, Epi epi, bool xcd_map = false) {
  const int tm = M / 128, tn = N / 128, nt = tm * tn;
  const int tid_ = TIDX, lane = tid_ & 63, wave = tid_ >> 6, wm = wave >> 1, wn = wave & 1;
  if (xcd_map && (nblk & 7) == 0 && tn >= 8) {
    const int x = bid & 7, lb = bid >> 3, nl = nblk >> 3;
    const int cnt = (tn - x + 7) >> 3;
    for (int lt = lb; lt < tm * cnt; lt += nl) {
      int m0 = (lt / cnt) * 128, n0 = (x + 8 * (lt % cnt)) * 128;
      f32x4 acc[4][4];
#pragma unroll
      for (int i = 0; i < 4; i++)
#pragma unroll
        for (int j = 0; j < 4; j++) acc[i][j] = (f32x4){0.f, 0.f, 0.f, 0.f};
      gemm_core<4>(acc, A + (size_t)m0 * lda, lda, B + (size_t)n0 * ldb, ldb, K, smem);
#pragma unroll
      for (int i = 0; i < 4; i++)
#pragma unroll
        for (int j = 0; j < 4; j++) epi(m0 + wm * 64 + i * 16 + (lane & 15), n0 + wn * 64 + j * 16 + (lane >> 4) * 4, acc[i][j]);
    }
    rot += nt;
    return;
  }
  if (nt * 2 <= nblk) {
    const int tn2 = N / 64, nt2 = tm * tn2;
    for (int t = bid; t < nt2; t += nblk) {
      int m0 = (t / tn2) * 128, n0 = (t % tn2) * 64;
      f32x4 acc[4][2];
#pragma unroll
      for (int i = 0; i < 4; i++)
#pragma unroll
        for (int j = 0; j < 2; j++) acc[i][j] = (f32x4){0.f, 0.f, 0.f, 0.f};
      gemm_core<2>(acc, A + (size_t)m0 * lda, lda, B + (size_t)n0 * ldb, ldb, K, smem);
#pragma unroll
      for (int i = 0; i < 4; i++)
#pragma unroll
        for (int j = 0; j < 2; j++) epi(m0 + wm * 64 + i * 16 + (lane & 15), n0 + wn * 32 + j * 16 + (lane >> 4) * 4, acc[i][j]);
    }
    rot += nt;
    return;
  }
  int first = (bid + nblk - (rot % nblk)) % nblk;
  for (int t = first; t < nt; t += nblk) {
    int m0 = (t / tn) * 128, n0 = (t % tn) * 128;
    f32x4 acc[4][4];
#pragma unroll
    for (int i = 0; i < 4; i++)
#pragma unroll
      for (int j = 0; j < 4; j++) acc[i][j] = (f32x4){0.f, 0.f, 0.f, 0.f};
    gemm_core<4>(acc, A + (size_t)m0 * lda, lda, B + (size_t)n0 * ldb, ldb, K, smem);
#pragma unroll
    for (int i = 0; i < 4; i++)
#pragma unroll
      for (int j = 0; j < 4; j++) epi(m0 + wm * 64 + i * 16 + (lane & 15), n0 + wn * 64 + j * 16 + (lane >> 4) * 4, acc[i][j]);
  }
  rot += nt;
}

DEVI void phase_gemm_in(const Params& p, int l, const Grp& G, int bid, int nblk, char* smem, int part = 0) {
  const bf16_t* H = (const bf16_t*)(p.ws + OFF_H);
  const bf16_t* W = (const bf16_t*)(p.ws + OFF_WT) + (size_t)l * WT_LAYER + W_IN;
  bf16_t* U = (bf16_t*)(p.ws + OFF_U);
  float* lif = (float*)(p.ws + OFF_LIF);
  const float* ib = p.in[24] + l * 8;
  const float* fb = p.in[25] + l * 8;
  int rot = 0;
  const int nt0 = (part == 2) ? 45 : 0, ntn = (part == 0) ? 69 : (part == 1 ? 45 : 24);
  const int coff = nt0 * 128;
  gemm_tiles(H, 1024, W + (size_t)coff * 1024, 1024, G.TG, ntn * 128, 1024, rot, bid, nblk, smem, [&](int row, int col, f32x4 v) {
    col += coff;
    if (col >= DIN) return;
    if (col >= 4656) { for (int e = 0; e < 4; e++) v[e] = sigm(v[e]); }
    else if (col >= 1440 && col < 1456) {
      int j = col - 1440;
      for (int e = 0; e < 4; e++) {
        float x;
        if (j < 8) x = v[e] + ib[j + e];
        else { float z = v[e] + fb[j - 8 + e]; x = fminf(z, 0.f) - log1pf(__expf(-fabsf(z))); }
        lif[(size_t)row * 16 + j + e] = x;
      }
    }
    else if (col >= 416 && col < 672) { for (int e = 0; e < 4; e++) v[e] *= 0.125f; }
    else if (col >= 1456 && col < 1968) { for (int e = 0; e < 4; e++) v[e] = sigm(v[e]); }
    else if (col >= 4272 && col < 4400) { for (int e = 0; e < 4; e++) v[e] = tanhf(v[e]); }
    else if (col >= 4528 && col < 4656) { for (int e = 0; e < 4; e++) v[e] = sigm(v[e]); }
    *(uint2*)(U + (size_t)row * DIN + col) = pack4(v[0], v[1], v[2], v[3]);
  }, true);
}

DEVI void norm_rope64(float (&x)[8], const float* g, int j8, bool rope, float pr, float pc) {
  float ss = 0.f;
#pragma unroll
  for (int e = 0; e < 8; e++) ss += x[e] * x[e];
  ss += __shfl_xor(ss, 1); ss += __shfl_xor(ss, 2); ss += __shfl_xor(ss, 4);
  float rs = rsqrtf(ss * (1.f / 64.f) + 1e-6f);
#pragma unroll
  for (int e = 0; e < 8; e++) x[e] = x[e] * rs * g[j8 * 8 + e];
  if (rope) {
    float pos = (j8 < 4) ? pr : pc;
    int ib = (j8 & 1) * 8;
    bool second = (j8 & 2) != 0;
#pragma unroll
    for (int e = 0; e < 8; e++) {
      float other = __shfl_xor(x[e], 2);
      float ang = pos * exp2f(-(float)(ib + e) * 0.830482f);
      float c = __cosf(ang), s = __sinf(ang);
      x[e] = second ? x[e] * c + other * s : x[e] * c - other * s;
    }
  }
}
DEVI void unpack8(uint4 r, float (&x)[8]) {
  x[0] = lo16(r.x); x[1] = hi16(r.x); x[2] = lo16(r.y); x[3] = hi16(r.y);
  x[4] = lo16(r.z); x[5] = hi16(r.z); x[6] = lo16(r.w); x[7] = hi16(r.w);
}
DEVI uint4 pack8(const float (&x)[8]) {
  uint4 r; r.x = pack2(x[0], x[1]); r.y = pack2(x[2], x[3]); r.z = pack2(x[4], x[5]); r.w = pack2(x[6], x[7]); return r;
}

DEVI void phase_prepa(const Params& p, int l, const Grp& G, int bid, int nblk) {
  bf16_t* U = (bf16_t*)(p.ws + OFF_U);
  bf16_t* ckv = (bf16_t*)(p.ws + OFF_CKV);
  float* krope = (float*)(p.ws + OFF_KROPE);
  bf16_t* Qs = (bf16_t*)(p.ws + OFF_QS);
  bf16_t* Ks = (bf16_t*)(p.ws + OFF_KS);
  bf16_t* Vts = (bf16_t*)(p.ws + OFF_VTS);
  const int tid_ = TIDX, lane = tid_ & 63, wv = tid_ >> 6;
  const float* gq = p.in[17] + l * 256;
  const float* gkv = p.in[18] + l * 128;
  const float* gsq = p.in[28] + l * 64;
  const float* gsk = p.in[29] + l * 64;
  for (int t = bid * 4 + wv; t < G.TG; t += nblk * 4) {
    int sq = t / G.S, pos = t % G.S, key = sq * G.KS + pos;
    bf16_t* u = U + (size_t)t * DIN;
    size_t orow = (size_t)(sq * 2 + l) * 256 + pos;
    const uint2 raw_q = *(const uint2*)(u + lane * 4);
    const unsigned raw_kv = *(const unsigned*)(u + 256 + lane * 2);
    const bf16_t raw_kr = u[384 + (lane & 31)];
    const uint4 raw_sq = *(const uint4*)(u + 1968 + lane * 8);
    const uint4 raw_sk = *(const uint4*)(u + 2480 + (lane & 15) * 8);
    const uint4 raw_sv = *(const uint4*)(u + 2608 + (lane & 15) * 8);
    {
      float x0 = lo16(raw_q.x), x1 = hi16(raw_q.x), x2 = lo16(raw_q.y), x3 = hi16(raw_q.y);
      float ss = wave_sum(x0 * x0 + x1 * x1 + x2 * x2 + x3 * x3);
      float rs = rsqrtf(ss * (1.f / 256.f) + 1e-6f);
      float4 g = *(const float4*)(gq + lane * 4);
      *(uint2*)(u + lane * 4) = pack4(x0 * rs * g.x, x1 * rs * g.y, x2 * rs * g.z, x3 * rs * g.w);
    }
    {
      float x0 = lo16(raw_kv), x1 = hi16(raw_kv);
      float ss = wave_sum(x0 * x0 + x1 * x1);
      float rs = rsqrtf(ss * (1.f / 128.f) + 1e-6f);
      float c0 = x0 * rs * gkv[lane * 2], c1 = x1 * rs * gkv[lane * 2 + 1];
      *(unsigned*)(ckv + (size_t)key * 128 + lane * 2) = pack2(c0, c1);
      if (!G.sample) *(float2*)(p.out + O_CKV + orow * 128 + lane * 2) = make_float2(c0, c1);
    }
    if (lane < 32) {
      float x = bf2f(raw_kr);
      krope[(size_t)key * 32 + lane] = x;
      if (!G.sample) p.out[O_KROPE + orow * 32 + lane] = x;
    }
    float pr = (float)(pos >> 6), pc = (float)(pos & 63);
    {
      float x[8];
      unpack8(raw_sq, x);
      norm_rope64(x, gsq, lane & 7, G.sample != 0, pr, pc);
      *(uint4*)(Qs + (size_t)t * 512 + lane * 8) = pack8(x);
    }
    {
      float x[8];
      unpack8(raw_sk, x);
      norm_rope64(x, gsk, lane & 7, G.sample != 0, pr, pc);
      if (lane < 16) {
        *(uint4*)(Ks + (size_t)key * 128 + lane * 8) = pack8(x);
        if (!G.sample) {
          float* o = p.out + O_SWAK + orow * 128 + lane * 8;
          *(float4*)o = make_float4(x[0], x[1], x[2], x[3]);
          *(float4*)(o + 4) = make_float4(x[4], x[5], x[6], x[7]);
        }
        float vv[8];
        unpack8(raw_sv, vv);
        int kvh = lane >> 3, d0 = (lane & 7) * 8;
#pragma unroll
        for (int e = 0; e < 8; e++) Vts[((size_t)(sq * 2 + kvh) * 64 + d0 + e) * G.KS + pos] = f2bf(vv[e]);
        if (!G.sample) {
          float* o = p.out + O_SWAV + orow * 128 + lane * 8;
          *(float4*)o = make_float4(vv[0], vv[1], vv[2], vv[3]);
          *(float4*)(o + 4) = make_float4(vv[4], vv[5], vv[6], vv[7]);
        }
      }
    }
  }
  if (G.sample) {
    for (int r = bid * 4 + wv; r < G.NS * 256; r += nblk * 4) {
      int sq = r >> 8, c = r & 255, b = G.batch0 + sq;
      size_t key = (size_t)sq * G.KS + G.S + c;
      size_t srow = (size_t)(b * 2 + l) * 256 + c;
      float2 a = *(const float2*)(p.in[3] + srow * 128 + lane * 2);
      *(unsigned*)(ckv + key * 128 + lane * 2) = pack2(a.x, a.y);
      if (lane < 32) krope[key * 32 + lane] = p.in[4][srow * 32 + lane];
      float2 kk = *(const float2*)(p.in[5] + srow * 128 + lane * 2);
      *(unsigned*)(Ks + key * 128 + lane * 2) = pack2(kk.x, kk.y);
      float2 vv = *(const float2*)(p.in[6] + srow * 128 + lane * 2);
      int idx = lane * 2, kvh = idx >> 6, d = idx & 63;
      Vts[((size_t)(sq * 2 + kvh) * 64 + d) * G.KS + G.S + c] = f2bf(vv.x);
      Vts[((size_t)(sq * 2 + kvh) * 64 + d + 1) * G.KS + G.S + c] = f2bf(vv.y);
    }
  }
}

DEVI void phase_gemm_small(const Params& p, int l, const Grp& G, int bid, int nblk, char* smem, int mode = 0) {
  const bf16_t* WT = (const bf16_t*)(p.ws + OFF_WT) + (size_t)l * WT_LAYER;
  bf16_t* U = (bf16_t*)(p.ws + OFF_U);
  bf16_t* Qb = (bf16_t*)(p.ws + OFF_Q);
  bf16_t* ckv = (bf16_t*)(p.ws + OFF_CKV);
  bf16_t* knope = (bf16_t*)(p.ws + OFF_KNOPE);
  bf16_t* Vt = (bf16_t*)(p.ws + OFF_VT);
  bf16_t* wa = (bf16_t*)(p.ws + OFF_WA);
  bf16_t* gb = (bf16_t*)(p.ws + OFF_G);
  const int KS = G.KS;
  const int tid_ = TIDX, lane = tid_ & 63, wave = tid_ >> 6, wm = wave >> 1, wn = wave & 1;
  const int t_kv = (G.NK / 128) * 8, t_q = (G.TG / 128) * 6, t_l = (G.TG / 128) * 4;
  const int total = t_kv + t_q + 5 * t_l;
  const int t_begin = (mode == 2) ? t_kv + t_q : 0, t_end = (mode == 1) ? t_kv + t_q : total;
  for (int t = t_begin + bid; t < t_end; t += nblk) {
    int job, tt = t;
    if (tt < t_kv) job = 0;
    else if ((tt -= t_kv) < t_q) job = 1;
    else { tt -= t_q; job = 2 + tt / t_l; tt = tt % t_l; }
    const bf16_t *A, *B;
    int lda, ldb, K, tn;
    if (job == 0) { A = ckv; lda = 128; B = WT + W_UKV; ldb = 128; K = 128; tn = 8; }
    else if (job == 1) { A = U; lda = DIN; B = WT + W_UQ; ldb = 256; K = 256; tn = 6; }
    else if (job < 4) { int d = job - 2; A = U + 4272 + d * 64; lda = DIN; B = WT + W_W2 + d * 32768; ldb = 64; K = 64; tn = 4; }
    else if (job < 6) { int d = job - 4; A = U + 4400 + d * 64; lda = DIN; B = WT + W_A2 + d * 32768; ldb = 64; K = 64; tn = 4; }
    else { A = U + 4528; lda = DIN; B = WT + W_G2; ldb = 128; K = 128; tn = 4; }
    const int m0 = (tt / tn) * 128, n0 = (tt % tn) * 128;
    f32x4 acc[4][4];
#pragma unroll
    for (int i = 0; i < 4; i++)
#pragma unroll
      for (int j = 0; j < 4; j++) acc[i][j] = (f32x4){0.f, 0.f, 0.f, 0.f};
    gemm_core<4>(acc, A + (size_t)m0 * lda, lda, B + (size_t)n0 * ldb, ldb, K, smem);
#pragma unroll
    for (int i = 0; i < 4; i++)
#pragma unroll
      for (int j = 0; j < 4; j++) {
        const int row = m0 + wm * 64 + i * 16 + (lane & 15), col = n0 + wn * 64 + j * 16 + (lane >> 4) * 4;
        f32x4 v = acc[i][j];
        if (job == 0) {
          int hh = col >> 7, cc = col & 127;
          if (cc < 64) *(uint2*)(knope + (size_t)row * 512 + hh * 64 + cc) = pack4(v[0], v[1], v[2], v[3]);
          else {
            int sq = row / KS, pos = row % KS;
#pragma unroll
            for (int e = 0; e < 4; e++) Vt[((size_t)(sq * 8 + hh) * 64 + cc - 64 + e) * KS + pos] = f2bf(v[e]);
          }
        } else if (job == 1) {
          *(uint2*)(Qb + (size_t)row * 768 + col) = pack4(v[0], v[1], v[2], v[3]);
        } else if (job < 6) {
          int d = (job - 2) & 1, isa = job >= 4;
          const float* b0 = (isa ? p.in[34] : p.in[32]) + (l * 2 + d) * 512 + col;
          float4 bb = *(const float4*)b0;
          *(uint2*)(wa + (size_t)row * 2048 + isa * 1024 + d * 512 + col) = pack4(v[0] + bb.x, v[1] + bb.y, v[2] + bb.z, v[3] + bb.w);
        } else {
          *(uint2*)(gb + (size_t)row * 512 + col) = pack4(v[0], v[1], v[2], v[3]);
        }
      }
  }
}

DEVI void rope_pair(float (&a)[8], float (&b)[8], float pos) {
#pragma unroll
  for (int e = 0; e < 8; e++) {
    float ang = pos * exp2f(-(float)e * 1.660964f);
    float c = __cosf(ang), s = __sinf(ang);
    float na = a[e] * c - b[e] * s, nb = b[e] * c + a[e] * s;
    a[e] = na; b[e] = nb;
  }
}
DEVI void phase_prepb(const Params& p, int l, const Grp& G, int bid, int nblk) {
  bf16_t* Qb = (bf16_t*)(p.ws + OFF_Q);
  const bf16_t* knope = (const bf16_t*)(p.ws + OFF_KNOPE);
  const float* krope = (const float*)(p.ws + OFF_KROPE);
  bf16_t* Kb = (bf16_t*)(p.ws + OFF_K);
  const float* gqn = p.in[21] + l * 96;
  const float* gkn = p.in[22] + l * 96;
  const int nq = G.TG * 8, nk = G.NK * 8, ntot = nq + nk;
  const int tid_ = TIDX, lane = tid_ & 63, wv = tid_ >> 6;
  const int j = lane & 15;
  const int stride = nblk * 16;
  for (int idx0 = (bid * 4 + wv) * 4 + (lane >> 4); idx0 < ntot; idx0 += 2 * stride) {
    float x[2][8];
    int rowv[2], hdv[2], posv[2];
    bool isqv[2], act[2];
#pragma unroll
    for (int u = 0; u < 2; u++) {
      int idx = idx0 + u * stride;
      act[u] = idx < ntot;
      if (!act[u]) idx = idx0;
      bool isq = idx < nq;
      int id = isq ? idx : idx - nq;
      int row = id >> 3, hd = id & 7;
      isqv[u] = isq; rowv[u] = row; hdv[u] = hd;
      posv[u] = isq ? (row % G.S) : (row % G.KS);
#pragma unroll
      for (int e = 0; e < 8; e++) x[u][e] = 0.f;
      if (isq) {
        if (j < 12) unpack8(*(const uint4*)(Qb + (size_t)row * 768 + hd * 96 + j * 8), x[u]);
      } else {
        if (j < 8) unpack8(*(const uint4*)(knope + (size_t)row * 512 + hd * 64 + j * 8), x[u]);
        else if (j < 12) {
          const float* kr = krope + (size_t)row * 32 + (j - 8) * 8;
          float4 a = *(const float4*)kr, b2 = *(const float4*)(kr + 4);
          x[u][0] = a.x; x[u][1] = a.y; x[u][2] = a.z; x[u][3] = a.w; x[u][4] = b2.x; x[u][5] = b2.y; x[u][6] = b2.z; x[u][7] = b2.w;
        }
      }
    }
#pragma unroll
    for (int u = 0; u < 2; u++) {
      const bool isq = isqv[u];
      const int pos = posv[u];
      const bool rope = G.sample && (isq || pos < G.S);
      const float* g = isq ? gqn : gkn;
      float ss = 0.f;
#pragma unroll
      for (int e = 0; e < 8; e++) ss += x[u][e] * x[u][e];
      ss = row16_sum(ss);
      float rs = rsqrtf(ss * (1.f / 96.f) + 1e-6f);
      const int jj = j < 12 ? j : 0;
#pragma unroll
      for (int e = 0; e < 8; e++) x[u][e] = x[u][e] * rs * g[jj * 8 + e];
      {
        int c = j - 8;
        float posf = (c < 2) ? (float)(pos >> 6) : (float)(pos & 63);
        bool second = (c & 1) != 0;
#pragma unroll
        for (int e = 0; e < 8; e++) {
          float other = __shfl_xor(x[u][e], 1);
          float ang = posf * exp2f(-(float)e * 1.660964f);
          float cs = __cosf(ang), sn = __sinf(ang);
          float r = second ? x[u][e] * cs + other * sn : x[u][e] * cs - other * sn;
          if (rope && j >= 8) x[u][e] = r;
        }
      }
      if (j < 12 && act[u]) {
        bf16_t* dst = (isq ? Qb : Kb) + (size_t)rowv[u] * 768 + hdv[u] * 96 + j * 8;
        *(uint4*)dst = pack8(x[u]);
      }
    }
  }
}

DEVI float row32_sum(float x) {
  x = row16_sum(x);
  float a = x, b2 = x;
  asm volatile("s_nop 1\n\tv_permlane16_swap_b32 %0, %1" : "+v"(a), "+v"(b2));
  return a + b2;
}
DEVI void rwkv_item(const Params& p, int l, const Grp& G, int it, char* smem) {
  const int tid = TIDX, lane = tid & 63, wv = tid >> 6;
  const int rg = it & 7, d = (it >> 3) & 1, hd = (it >> 4) & 7, sq = it >> 7;
  const int b = G.batch0 + sq;
  const int rloc = wv * 2 + (lane >> 5), row = rg * 8 + rloc, pq = lane & 31;
  const int S = G.S;
  const bf16_t* U = (const bf16_t*)(p.ws + OFF_U);
  const bf16_t* wa = (const bf16_t*)(p.ws + OFF_WA);
  float* yout = (float*)(p.ws + OFF_YRW) + (size_t)d * G.TG * 512;
  float S0 = 0.f, S1 = 0.f;
  const size_t sbase = ((((size_t)(b * 2 + l) * 2 + d) * 8 + hd) * 64 + row) * 64 + pq * 2;
  if (G.sample) { float2 s = *(const float2*)(p.in[10] + sbase); S0 = s.x; S1 = s.y; }
  float* buf = (float*)smem;
  float* vb = buf + 2 * 16 * 320;
  const int ts = tid >> 4, kq = tid & 15;
  const float4 kk4 = *(const float4*)(p.in[37] + l * 512 + hd * 64 + kq * 4);
  const float4 ka4 = *(const float4*)(p.in[38] + l * 512 + hd * 64 + kq * 4);
  struct RwRegs { unsigned rr0, rr1, rk0, rk1, rw0, rw1, ra0, ra1, rv; };
  RwRegs RA, RB;
  auto issue = [&](int c, RwRegs& R) {
    int i = c * 16 + ts, pos = d ? S - 1 - i : i;
    size_t t = (size_t)sq * S + pos;
    const bf16_t* u = U + t * DIN;
    const unsigned* q;
    q = (const unsigned*)(u + 2736 + hd * 64 + kq * 4); R.rr0 = q[0]; R.rr1 = q[1];
    q = (const unsigned*)(u + 3248 + hd * 64 + kq * 4); R.rk0 = q[0]; R.rk1 = q[1];
    R.rv = u[3760 + hd * 64 + rg * 8 + (kq & 7)];
    q = (const unsigned*)(wa + t * 2048 + d * 512 + hd * 64 + kq * 4); R.rw0 = q[0]; R.rw1 = q[1];
    q = (const unsigned*)(wa + t * 2048 + 1024 + d * 512 + hd * 64 + kq * 4); R.ra0 = q[0]; R.ra1 = q[1];
  };
  auto stage = [&](int nb, const RwRegs& R) {
    float k0 = lo16(R.rk0), k1 = hi16(R.rk0), k2 = lo16(R.rk1), k3 = hi16(R.rk1);
    float q0 = k0 * kk4.x, q1 = k1 * kk4.y, q2 = k2 * kk4.z, q3 = k3 * kk4.w;
    float ss = row16_sum(q0 * q0 + q1 * q1 + q2 * q2 + q3 * q3);
    float rs = rsqrtf(ss + 1e-12f);
    float4 kh = make_float4(q0 * rs, q1 * rs, q2 * rs, q3 * rs);
    float4 a = make_float4(sigm(lo16(R.ra0)), sigm(hi16(R.ra0)), sigm(lo16(R.ra1)), sigm(hi16(R.ra1)));
    float4 w = make_float4(__expf(-0.6065306597f * sigm(lo16(R.rw0))), __expf(-0.6065306597f * sigm(hi16(R.rw0))),
                           __expf(-0.6065306597f * sigm(lo16(R.rw1))), __expf(-0.6065306597f * sigm(hi16(R.rw1))));
    float4 kt = make_float4(k0 * (1.f + (a.x - 1.f) * ka4.x), k1 * (1.f + (a.y - 1.f) * ka4.y), k2 * (1.f + (a.z - 1.f) * ka4.z), k3 * (1.f + (a.w - 1.f) * ka4.w));
    float4 akh = make_float4(a.x * kh.x, a.y * kh.y, a.z * kh.z, a.w * kh.w);
    float4 r4 = make_float4(lo16(R.rr0), hi16(R.rr0), lo16(R.rr1), hi16(R.rr1));
    float* bp = buf + (nb * 16 + ts) * 320 + kq * 4;
    *(float4*)(bp) = kh; *(float4*)(bp + 64) = w; *(float4*)(bp + 128) = akh; *(float4*)(bp + 192) = kt; *(float4*)(bp + 256) = r4;
    if (kq < 8) vb[(nb * 16 + ts) * 8 + kq] = lo16(R.rv);
  };
  auto steps = [&](int c) {
    const int cb = c & 1;
    float yp[16];
    const float* bp0 = buf + (cb * 16) * 320 + pq * 2;
    const float* vp0 = vb + (cb * 16) * 8 + rloc;
    float2 kh = *(const float2*)(bp0), w2 = *(const float2*)(bp0 + 64), akh = *(const float2*)(bp0 + 128), kt = *(const float2*)(bp0 + 192), r2 = *(const float2*)(bp0 + 256);
    float vv = vp0[0];
#pragma unroll
    for (int s = 0; s < 16; s++) {
      float2 khn = kh, w2n = w2, akhn = akh, ktn = kt, r2n = r2; float vvn = vv;
      if (s < 15) {
        const float* bp = bp0 + (s + 1) * 320;
        khn = *(const float2*)(bp); w2n = *(const float2*)(bp + 64); akhn = *(const float2*)(bp + 128); ktn = *(const float2*)(bp + 192); r2n = *(const float2*)(bp + 256);
        vvn = vp0[(s + 1) * 8];
      }
      float sk = row32_sum(S0 * kh.x + S1 * kh.y);
      S0 = (S0 * w2.x + vv * kt.x) - sk * akh.x;
      S1 = (S1 * w2.y + vv * kt.y) - sk * akh.y;
      yp[s] = S0 * r2.x + S1 * r2.y;
      kh = khn; w2 = w2n; akh = akhn; kt = ktn; r2 = r2n; vv = vvn;
    }
    float t8[8], u4[4], v2[2];
#pragma unroll
    for (int j = 0; j < 8; j++) {
      float a = yp[j], b2 = yp[j + 8];
      asm volatile("s_nop 1\n\tv_permlane16_swap_b32 %0, %1\n\ts_nop 1" : "+v"(a), "+v"(b2));
      t8[j] = a + b2;
    }
    const int q = lane & 15;
#pragma unroll
    for (int j = 0; j < 4; j++) { float A = dpp_add<0x128>(t8[j]), B = dpp_add<0x128>(t8[j + 4]); u4[j] = (q & 8) ? B : A; }
#pragma unroll
    for (int j = 0; j < 2; j++) { float A = dpp_add<0x141>(u4[j]), B = dpp_add<0x141>(u4[j + 2]); v2[j] = (q & 4) ? B : A; }
    float wA = dpp_add<0x4E>(v2[0]), wB = dpp_add<0x4E>(v2[1]);
    float wsel = (q & 2) ? wB : wA;
    float yfin = dpp_add<0xB1>(wsel);
    if ((q & 1) == 0) {
      const int sidx = ((lane >> 4) & 1) * 8 + ((q >> 3) & 1) * 4 + ((q >> 2) & 1) * 2 + ((q >> 1) & 1);
      int i = c * 16 + sidx, pos = d ? S - 1 - i : i;
      yout[((size_t)sq * S + pos) * 512 + hd * 64 + row] = yfin;
    }
  };
  const int nch = S / 16;
  __syncthreads();
  issue(0, RA); stage(0, RA);
  issue(1, RB);
  __syncthreads();
  for (int c = 0; c < nch; c += 2) {
    if (c + 2 < nch) issue(c + 2, RA);
    steps(c);
    stage(1, RB);
    __syncthreads();
    if (c + 3 < nch) issue(c + 3, RB);
    steps(c + 1);
    if (c + 2 < nch) stage(0, RA);
    __syncthreads();
  }
  if (!G.sample) *(float2*)(p.out + O_RW + sbase) = make_float2(S0, S1);
}

DEVI void mlstm_item(const Params& p, int l, const Grp& G, int it, char* smem) {
  const int tid = TIDX, lane = tid & 63, wv = tid >> 6;
  const int d = it & 1, hh = (it >> 1) & 3, sq = it >> 3;
  const int b = G.batch0 + sq, S = G.S;
  const bf16_t* U = (const bf16_t*)(p.ws + OFF_U);
  const float* lif = (const float*)(p.ws + OFF_LIF);
  float* hml = (float*)(p.ws + OFF_HML) + (size_t)d * G.TG * 512;
  bf16_t* sQ = (bf16_t*)smem;
  bf16_t* sK = sQ + 64 * 72;
  bf16_t* sVt = sK + 64 * 72;
  bf16_t* sKw = sVt + 144 * 72;
  bf16_t* sW = sKw + 64 * 72;
  bf16_t* sCt = sW + 64 * 72;
  float* gbuf = (float*)(sCt + 144 * 72);
  const size_t base = (((size_t)(b * 2 + l) * 2 + d) * 4 + hh);
  f32x4 ct[9];
  float m = 0.f;
  const int dcol0 = 16 * wv + (lane >> 4) * 4;
#pragma unroll
  for (int mt = 0; mt < 9; mt++) ct[mt] = (f32x4){0.f, 0.f, 0.f, 0.f};
  if (G.sample) {
    m = p.in[9][base];
#pragma unroll
    for (int mt = 0; mt < 8; mt++)
#pragma unroll
      for (int e = 0; e < 4; e++) ct[mt][e] = p.in[7][base * 8192 + (size_t)(dcol0 + e) * 128 + mt * 16 + (lane & 15)];
    if ((lane & 15) == 0)
#pragma unroll
      for (int e = 0; e < 4; e++) ct[8][e] = p.in[8][base * 64 + dcol0 + e];
  }
  u32x4 rq[2], rk[2], rvv[4];
  float liv = 0.f, lfv = 0.f;
  auto gload = [&](int c) {
#pragma unroll
    for (int i = 0; i < 2; i++) {
      int id = tid + i * 256, r = id >> 3, ck = id & 7;
      int ii = c * 64 + r, pos = d ? S - 1 - ii : ii;
      const bf16_t* u = U + ((size_t)sq * S + pos) * DIN;
      rq[i] = *(const u32x4*)(u + 416 + hh * 64 + ck * 8);
      rk[i] = *(const u32x4*)(u + 672 + hh * 64 + ck * 8);
    }
#pragma unroll
    for (int i = 0; i < 4; i++) {
      int id = tid + i * 256, r = id >> 4, ck = id & 15;
      int ii = c * 64 + r, pos = d ? S - 1 - ii : ii;
      rvv[i] = *(const u32x4*)(U + ((size_t)sq * S + pos) * DIN + 928 + hh * 128 + ck * 8);
    }
    if (wv == 0) {
      int ii = c * 64 + lane, pos = d ? S - 1 - ii : ii;
      size_t t = (size_t)sq * S + pos;
      liv = lif[t * 16 + d * 4 + hh]; lfv = lif[t * 16 + 8 + d * 4 + hh];
    }
  };
  auto gscan = [&](int c) {
    float bs = lfv;
#pragma unroll
    for (int o = 1; o < 64; o <<= 1) { float n = __shfl_up(bs, o); if (lane >= o) bs += n; }
    float u = liv - bs, pm = u;
#pragma unroll
    for (int o = 1; o < 64; o <<= 1) { float n = __shfl_up(pm, o); if (lane >= o) pm = fmaxf(pm, n); }
    float bL = __shfl(bs, 63);
    float gm = bL + u;
#pragma unroll
    for (int o = 32; o > 0; o >>= 1) gm = fmaxf(gm, __shfl_xor(gm, o));
    float* gb = gbuf + (c & 1) * 200;
    gb[lane] = bs; gb[64 + lane] = u; gb[128 + lane] = pm;
    if (lane == 0) { gb[192] = bL; gb[193] = gm; }
  };
  __syncthreads();
  for (int i = tid; i < 16 * 64; i += NTHREADS) { int r = i >> 6, c = i & 63; sVt[(128 + r) * 72 + c] = (r == 0) ? (bf16_t)0x3F80 : (bf16_t)0; }
#pragma unroll
  for (int mt = 0; mt < 9; mt++) *(uint2*)(sCt + (mt * 16 + (lane & 15)) * 72 + dcol0) = pack4(ct[mt][0], ct[mt][1], ct[mt][2], ct[mt][3]);
  gload(0);
  if (wv == 0) gscan(0);
  const int nch = S / 64;
  for (int c = 0; c < nch; c++) {
    __syncthreads();
#pragma unroll
    for (int i = 0; i < 2; i++) {
      int id = tid + i * 256, r = id >> 3, ck = id & 7;
      *(u32x4*)(sQ + r * 72 + ck * 8) = rq[i];
      *(u32x4*)(sK + r * 72 + ck * 8) = rk[i];
    }
#pragma unroll
    for (int i = 0; i < 4; i++) {
      int id = tid + i * 256, r = id >> 4, ck = id & 15;
      u32x4 raw = rvv[i];
      bf16_t* dst = sVt + (ck * 8) * 72 + r;
      dst[0] = (bf16_t)(raw.x & 0xffff); dst[72] = (bf16_t)(raw.x >> 16);
      dst[144] = (bf16_t)(raw.y & 0xffff); dst[216] = (bf16_t)(raw.y >> 16);
      dst[288] = (bf16_t)(raw.z & 0xffff); dst[360] = (bf16_t)(raw.z >> 16);
      dst[432] = (bf16_t)(raw.w & 0xffff); dst[504] = (bf16_t)(raw.w >> 16);
    }
    if (c + 1 < nch) gload(c + 1);
    __syncthreads();
    const float* gb = gbuf + (c & 1) * 200;
    const float bL = gb[192], gmax = gb[193];
    const float mnew = fmaxf(bL + m, gmax);
    const float decay = __expf(bL + m - mnew);
#pragma unroll
    for (int i = 0; i < 2; i++) {
      int id = tid + i * 256, r = id >> 3, ck = id & 7;
      float x[8];
      unpack8(*(const uint4*)(sK + r * 72 + ck * 8), x);
      float wk = __expf(bL + gb[64 + r] - mnew);
#pragma unroll
      for (int e = 0; e < 8; e++) sKw[(ck * 8 + e) * 72 + r] = f2bf(wk * x[e]);
    }
    const int trow = 16 * wv + (lane & 15);
    const float bt = gb[trow];
    const float mtt = bt + fmaxf(m, gb[128 + trow]);
    const float ain = __expf(bt + m - mtt);
    {
      f32x4 s4[4];
#pragma unroll
      for (int nt = 0; nt < 4; nt++) s4[nt] = (f32x4){0.f, 0.f, 0.f, 0.f};
#pragma unroll 1
      for (int kk = 0; kk < 2; kk++) {
        bf16x8 a = ldfrag_l(sQ, 72, 16 * wv, kk * 32, lane);
#pragma unroll
        for (int nt = 0; nt < 4; nt++) s4[nt] = mma(a, ldfrag_l(sK, 72, nt * 16, kk * 32, lane), s4[nt]);
      }
#pragma unroll
      for (int nt = 0; nt < 4; nt++) {
        float wv4[4];
#pragma unroll
        for (int e = 0; e < 4; e++) {
          int s = nt * 16 + (lane >> 4) * 4 + e;
          wv4[e] = (s <= trow) ? s4[nt][e] * __expf(bt + gb[64 + s] - mtt) : 0.f;
        }
        *(uint2*)(sW + trow * 72 + nt * 16 + (lane >> 4) * 4) = pack4(wv4[0], wv4[1], wv4[2], wv4[3]);
      }
    }
    __syncthreads();
    {
      f32x4 n1[9];
#pragma unroll
      for (int nt = 0; nt < 9; nt++) n1[nt] = (f32x4){0.f, 0.f, 0.f, 0.f};
#pragma unroll 1
      for (int kk = 0; kk < 2; kk++) {
        bf16x8 aQ = ldfrag_l(sQ, 72, 16 * wv, kk * 32, lane);
#pragma unroll
        for (int nt = 0; nt < 9; nt++) n1[nt] = mma(aQ, ldfrag_l(sCt, 72, nt * 16, kk * 32, lane), n1[nt]);
      }
#pragma unroll
      for (int nt = 0; nt < 9; nt++) n1[nt] *= ain;
#pragma unroll 1
      for (int kk = 0; kk < 2; kk++) {
        bf16x8 aW = ldfrag_l(sW, 72, 16 * wv, kk * 32, lane);
#pragma unroll
        for (int nt = 0; nt < 9; nt++) n1[nt] = mma(aW, ldfrag_l(sVt, 72, nt * 16, kk * 32, lane), n1[nt]);
      }
      float den = __shfl(n1[8][0], lane & 15);
      float inv = 1.f / fmaxf(fabsf(den), __expf(-mtt));
      int ii = c * 64 + trow, pos = d ? S - 1 - ii : ii;
      float* ho = hml + ((size_t)sq * S + pos) * 512 + hh * 128 + (lane >> 4) * 4;
#pragma unroll
      for (int nt = 0; nt < 8; nt++) *(float4*)(ho + nt * 16) = make_float4(n1[nt][0] * inv, n1[nt][1] * inv, n1[nt][2] * inv, n1[nt][3] * inv);
    }
#pragma unroll
    for (int mt = 0; mt < 9; mt++) ct[mt] *= decay;
#pragma unroll 1
    for (int kk = 0; kk < 2; kk++) {
      bf16x8 bk = ldfrag_l(sKw, 72, 16 * wv, kk * 32, lane);
#pragma unroll
      for (int mt = 0; mt < 9; mt++) ct[mt] = mma(ldfrag_l(sVt, 72, mt * 16, kk * 32, lane), bk, ct[mt]);
    }
    mfma_settle9(ct);
    __syncthreads();
#pragma unroll
    for (int mt = 0; mt < 9; mt++) *(uint2*)(sCt + (mt * 16 + (lane & 15)) * 72 + dcol0) = pack4(ct[mt][0], ct[mt][1], ct[mt][2], ct[mt][3]);
    if (wv == 0 && c + 1 < nch) gscan(c + 1);
    m = mnew;
  }
  if (!G.sample) {
#pragma unroll
    for (int mt = 0; mt < 8; mt++)
#pragma unroll
      for (int e = 0; e < 4; e++) p.out[O_MLC + base * 8192 + (size_t)(dcol0 + e) * 128 + mt * 16 + (lane & 15)] = ct[mt][e];
    if ((lane & 15) == 0)
#pragma unroll
      for (int e = 0; e < 4; e++) p.out[O_MLN + base * 64 + dcol0 + e] = ct[8][e];
    if (tid == 0) p.out[O_MLM + base] = m;
  }
}

template <int DQK, int DV, bool MASKED>
DEVI void attn_tile(const bf16_t* Qp, int ldq, const bf16_t* Kp, int ldk, const bf16_t* Vp, int KS, bf16_t* Yp, int ldy,
                    int q0, int S, int CTX, int W, bool has_sink, float sink, float scale, char* smem) {
  constexpr int KSTR = DQK + 8, NKK = DQK / 32, NDT = DV / 16;
  constexpr int NKC = (64 * (DQK / 8)) / NTHREADS;
  constexpr int NVC = (DV * 8) / NTHREADS;
  const int tid = TIDX, lane = tid & 63, wv = tid >> 6;
  bf16_t* sK = (bf16_t*)smem;
  bf16_t* sV = sK + 64 * KSTR;
  bf16_t* sP = sV + DV * 72 + wv * 32 * 72;
  const float cs = scale * 1.44269504f;
  bf16x8 qf[2][NKK];
#pragma unroll
  for (int i = 0; i < 2; i++)
#pragma unroll
    for (int kk = 0; kk < NKK; kk++)
      qf[i][kk] = *(const bf16x8*)(Qp + (size_t)(q0 + wv * 32 + i * 16 + (lane & 15)) * ldq + kk * 32 + (lane >> 4) * 8);
  f32x4 o[2][NDT];
  float mrow[2], lrow[2];
#pragma unroll
  for (int i = 0; i < 2; i++) {
#pragma unroll
    for (int dt = 0; dt < NDT; dt++) o[i][dt] = (f32x4){0.f, 0.f, 0.f, 0.f};
    mrow[i] = has_sink ? sink * 1.44269504f : -1e30f;
    lrow[i] = (has_sink && (lane >> 4) == 0) ? 1.f : 0.f;
  }
  int lo = q0 - W; if (lo < 0) lo = 0; lo &= ~63;
  int hi = q0 + 128 + W; if (hi > S) hi = S; hi = (hi + 63) & ~63;
  const int n1 = (hi - lo) / 64, n2 = CTX / 64, ntile = n1 + n2;
  u32x4 rk[NKC], rv[NVC];
  auto gload = [&](int it) {
    const int k0 = it < n1 ? lo + it * 64 : S + (it - n1) * 64;
#pragma unroll
    for (int c = 0; c < NKC; c++) {
      int id = tid + c * NTHREADS, r = id / (DQK / 8), ck = id % (DQK / 8);
      rk[c] = *(const u32x4*)(Kp + (size_t)(k0 + r) * ldk + ck * 8);
    }
#pragma unroll
    for (int c = 0; c < NVC; c++) {
      int id = tid + c * NTHREADS, r = id >> 3, ck = id & 7;
      rv[c] = *(const u32x4*)(Vp + (size_t)r * KS + k0 + ck * 8);
    }
  };
  gload(0);
  for (int it = 0; it < ntile; it++) {
    const int k0 = it < n1 ? lo + it * 64 : S + (it - n1) * 64;
    __syncthreads();
#pragma unroll
    for (int c = 0; c < NKC; c++) {
      int id = tid + c * NTHREADS, r = id / (DQK / 8), ck = id % (DQK / 8);
      *(u32x4*)(sK + r * KSTR + ck * 8) = rk[c];
    }
#pragma unroll
    for (int c = 0; c < NVC; c++) {
      int id = tid + c * NTHREADS, r = id >> 3, ck = id & 7;
      *(u32x4*)(sV + r * 72 + ck * 8) = rv[c];
    }
    __syncthreads();
    if (it + 1 < ntile) gload(it + 1);
    f32x4 s[2][4];
#pragma unroll
    for (int i = 0; i < 2; i++)
#pragma unroll
      for (int nt = 0; nt < 4; nt++) s[i][nt] = (f32x4){0.f, 0.f, 0.f, 0.f};
#pragma unroll
    for (int kk = 0; kk < NKK; kk++)
#pragma unroll
      for (int nt = 0; nt < 4; nt++) {
        bf16x8 bk = ldfrag_l(sK, KSTR, nt * 16, kk * 32, lane);
#pragma unroll
        for (int i = 0; i < 2; i++) s[i][nt] = mma(qf[i][kk], bk, s[i][nt]);
      }
#pragma unroll
    for (int i = 0; i < 2; i++) {
      float mx = -1e30f;
      if (MASKED) {
        const int qpos = q0 + wv * 32 + i * 16 + (lane & 15);
#pragma unroll
        for (int nt = 0; nt < 4; nt++)
#pragma unroll
          for (int e = 0; e < 4; e++) {
            int kidx = k0 + nt * 16 + (lane >> 4) * 4 + e;
            int dd = qpos - kidx; dd = dd < 0 ? -dd : dd;
            bool valid = (kidx >= S) || (dd <= W);
            float v = valid ? s[i][nt][e] * cs : -1e30f;
            s[i][nt][e] = v;
            mx = fmaxf(mx, v);
          }
      } else {
#pragma unroll
        for (int nt = 0; nt < 4; nt++)
#pragma unroll
          for (int e = 0; e < 4; e++) mx = fmaxf(mx, s[i][nt][e]);
        mx *= cs;
      }
      mx = fmaxf(mx, __shfl_xor(mx, 16)); mx = fmaxf(mx, __shfl_xor(mx, 32));
      float mn = fmaxf(mrow[i], mx);
      float alpha = __builtin_amdgcn_exp2f(mrow[i] - mn);
      mrow[i] = mn;
      float ls = 0.f;
#pragma unroll
      for (int nt = 0; nt < 4; nt++) {
        float pv[4];
#pragma unroll
        for (int e = 0; e < 4; e++) {
          if (MASKED) pv[e] = (s[i][nt][e] > -1e29f) ? __builtin_amdgcn_exp2f(s[i][nt][e] - mn) : 0.f;
          else pv[e] = __builtin_amdgcn_exp2f(__builtin_fmaf(s[i][nt][e], cs, -mn));
          ls += pv[e];
        }
        *(uint2*)(sP + (i * 16 + (lane & 15)) * 72 + nt * 16 + (lane >> 4) * 4) = pack4(pv[0], pv[1], pv[2], pv[3]);
      }
      lrow[i] = lrow[i] * alpha + ls;
#pragma unroll
      for (int dt = 0; dt < NDT; dt++) o[i][dt] *= alpha;
    }
    __builtin_amdgcn_fence(__ATOMIC_RELEASE, "wavefront");
    __builtin_amdgcn_wave_barrier();
    __builtin_amdgcn_fence(__ATOMIC_ACQUIRE, "wavefront");
#pragma unroll
    for (int kk = 0; kk < 2; kk++)
#pragma unroll
      for (int dt = 0; dt < NDT; dt++) {
        bf16x8 bv = ldfrag_l(sV, 72, dt * 16, kk * 32, lane);
#pragma unroll
        for (int i = 0; i < 2; i++) o[i][dt] = mma(ldfrag_l(sP, 72, i * 16, kk * 32, lane), bv, o[i][dt]);
      }
  }
#pragma unroll
  for (int i = 0; i < 2; i++) {
    float lsum = lrow[i];
    lsum += __shfl_xor(lsum, 16); lsum += __shfl_xor(lsum, 32);
    float inv = 1.f / lsum;
    bf16_t* yo = Yp + (size_t)(q0 + wv * 32 + i * 16 + (lane & 15)) * ldy + (lane >> 4) * 4;
#pragma unroll
    for (int dt = 0; dt < NDT; dt++) *(uint2*)(yo + dt * 16) = pack4(o[i][dt][0] * inv, o[i][dt][1] * inv, o[i][dt][2] * inv, o[i][dt][3] * inv);
  }
}

DEVI void attn_queues(const Params& p, int l, const Grp& G, char* smem, int* s_item, int* ctr) {
  const int nqt = G.S / 128;
  const int n_x = 2 * G.NS * nqt;
  bf16_t* Y = (bf16_t*)(p.ws + OFF_Y);
  const int x0 = blockIdx.x & 7;
#ifndef ATTNREP
#define ATTNREP 1
#endif
  for (int pass = 0; pass < ATTNREP; pass++)
  for (int xs = 0; xs < 8; xs++) {
    const int x = (x0 + xs) & 7;
    for (;;) {
      __syncthreads();
      if (TIDX == 0) *s_item = atomicAdd(ctr + 1 + pass * 16 + x, 1);
      __syncthreads();
      int it = *s_item;
      if (it >= n_x) break;
      const bool mla = it < G.NS * nqt;
      if (!mla) it -= G.NS * nqt;
      const int sq = it / nqt, qt = it % nqt, hd = x;
      if (mla) {
        attn_tile<96, 64, false>((const bf16_t*)(p.ws + OFF_Q) + (size_t)sq * G.S * 768 + hd * 96, 768,
                          (const bf16_t*)(p.ws + OFF_K) + (size_t)sq * G.KS * 768 + hd * 96, 768,
                          (const bf16_t*)(p.ws + OFF_VT) + (size_t)(sq * 8 + hd) * 64 * G.KS, G.KS,
                          Y + (size_t)sq * G.S * 2048 + hd * 64, 2048, qt * 128, G.S, G.CTX, 1 << 29, false, 0.f, 0.10206207f, smem);
      } else {
        int kvh = hd >> 2;
        attn_tile<64, 64, true>((const bf16_t*)(p.ws + OFF_QS) + (size_t)sq * G.S * 512 + hd * 64, 512,
                          (const bf16_t*)(p.ws + OFF_KS) + (size_t)sq * G.KS * 128 + kvh * 64, 128,
                          (const bf16_t*)(p.ws + OFF_VTS) + (size_t)(sq * 2 + kvh) * 64 * G.KS, G.KS,
                          Y + (size_t)sq * G.S * 2048 + 1024 + hd * 64, 2048, qt * 128, G.S, G.CTX, G.sample ? 128 : (1 << 29), true,
                          p.in[30][l * 8 + hd], 0.125f, smem);
      }
    }
  }
}

DEVI void chain_item(const Params& p, int l, const Grp& G, int it, int n_rw, char* smem) {
  if (it < n_rw) { __builtin_amdgcn_s_setprio(3); rwkv_item(p, l, G, it, smem); __builtin_amdgcn_s_setprio(0); }
  else { __builtin_amdgcn_s_setprio(2); mlstm_item(p, l, G, it - n_rw, smem); __builtin_amdgcn_s_setprio(0); }
}

DEVI void phase_mix(const Params& p, int l, int g, const Grp& G, char* smem, int* s_item, int coff) {
  int* ctr = (int*)(p.ws + OFF_CTR2) + ((coff ? 10 : 0) + l * 5 + g) * 32;
  const int n_rw = G.NS * 128, n_ml = G.NS * 8;
  const int n_chain = n_rw + n_ml;
  for (;;) {
    __syncthreads();
    if (TIDX == 0) *s_item = atomicAdd(ctr, 1);
    __syncthreads();
    int it = *s_item;
    if (it >= n_chain) break;
    chain_item(p, l, G, it, n_rw, smem);
  }
  attn_queues(p, l, G, smem, s_item, ctr);
}

DEVI void phase_post(const Params& p, int l, const Grp& G, int bid, int nblk) {
  const bf16_t* U = (const bf16_t*)(p.ws + OFF_U);
  const bf16_t* wa = (const bf16_t*)(p.ws + OFF_WA);
  const bf16_t* gb = (const bf16_t*)(p.ws + OFF_G);
  const float* hml = (const float*)(p.ws + OFF_HML);
  const float* yrw = (const float*)(p.ws + OFF_YRW);
  bf16_t* Y = (bf16_t*)(p.ws + OFF_Y);
  const int tid_ = TIDX, lane = tid_ & 63, wv = tid_ >> 6;
  const int c8 = lane * 8;
  const size_t dstr = (size_t)G.TG * 512;
  for (int t = bid * 4 + wv; t < G.TG; t += nblk * 4) {
    const bf16_t* u = U + (size_t)t * DIN;
    {
      const float* a = hml + (size_t)t * 512 + c8;
      float x[8];
      float4 f0 = *(const float4*)a, f1 = *(const float4*)(a + 4), b0 = *(const float4*)(a + dstr), b1 = *(const float4*)(a + dstr + 4);
      x[0] = f0.x + b0.x; x[1] = f0.y + b0.y; x[2] = f0.z + b0.z; x[3] = f0.w + b0.w;
      x[4] = f1.x + b1.x; x[5] = f1.y + b1.y; x[6] = f1.z + b1.z; x[7] = f1.w + b1.w;
      float ss = 0.f;
#pragma unroll
      for (int e = 0; e < 8; e++) ss += x[e] * x[e];
      ss += __shfl_xor(ss, 1); ss += __shfl_xor(ss, 2); ss += __shfl_xor(ss, 4); ss += __shfl_xor(ss, 8);
      float rs = rsqrtf(ss * (1.f / 128.f) + 1e-6f);
      const float* g = p.in[26] + l * 128 + (c8 & 127);
      float so[8];
      unpack8(*(const uint4*)(u + 1456 + c8), so);
#pragma unroll
      for (int e = 0; e < 8; e++) x[e] = x[e] * rs * g[e] * so[e];
      *(uint4*)(Y + (size_t)t * 2048 + 512 + c8) = pack8(x);
    }
    {
      const float* a = yrw + (size_t)t * 512 + c8;
      float y[8];
      float4 f0 = *(const float4*)a, f1 = *(const float4*)(a + 4), b0 = *(const float4*)(a + dstr), b1 = *(const float4*)(a + dstr + 4);
      y[0] = f0.x + b0.x; y[1] = f0.y + b0.y; y[2] = f0.z + b0.z; y[3] = f0.w + b0.w;
      y[4] = f1.x + b1.x; y[5] = f1.y + b1.y; y[6] = f1.z + b1.z; y[7] = f1.w + b1.w;
      float sm = 0.f;
#pragma unroll
      for (int e = 0; e < 8; e++) sm += y[e];
      sm += __shfl_xor(sm, 1); sm += __shfl_xor(sm, 2); sm += __shfl_xor(sm, 4);
      float mu = sm * (1.f / 64.f);
      float sv = 0.f;
#pragma unroll
      for (int e = 0; e < 8; e++) { y[e] -= mu; sv += y[e] * y[e]; }
      sv += __shfl_xor(sv, 1); sv += __shfl_xor(sv, 2); sv += __shfl_xor(sv, 4);
      float rs = rsqrtf(sv * (1.f / 64.f) + 64e-5f);
      float r[8], k[8], v[8];
      unpack8(*(const uint4*)(u + 2736 + c8), r);
      unpack8(*(const uint4*)(u + 3248 + c8), k);
      unpack8(*(const uint4*)(u + 3760 + c8), v);
      const float* ka = p.in[38] + l * 512 + c8;
      float sd = 0.f;
#pragma unroll
      for (int d = 0; d < 2; d++) {
        float ap[8];
        unpack8(*(const uint4*)(wa + (size_t)t * 2048 + 1024 + d * 512 + c8), ap);
        const float* uu = p.in[39] + (l * 2 + d) * 512 + c8;
#pragma unroll
        for (int e = 0; e < 8; e++) {
          float a_ = sigm(ap[e]);
          sd += r[e] * k[e] * (1.f + (a_ - 1.f) * ka[e]) * uu[e];
        }
      }
      sd += __shfl_xor(sd, 1); sd += __shfl_xor(sd, 2); sd += __shfl_xor(sd, 4);
      float gg[8];
      unpack8(*(const uint4*)(gb + (size_t)t * 512 + c8), gg);
      const float* gng = p.in[40] + l * 512 + c8;
      const float* gnb = p.in[41] + l * 512 + c8;
      float o[8];
#pragma unroll
      for (int e = 0; e < 8; e++) o[e] = (y[e] * rs * gng[e] + gnb[e] + sd * v[e]) * gg[e];
      *(uint4*)(Y + (size_t)t * 2048 + 1536 + c8) = pack8(o);
    }
  }
}

DEVI void phase_merge(const Params& p, int l, const Grp& G, int bid, int nblk, char* smem) {
  const bf16_t* WT = (const bf16_t*)(p.ws + OFF_WT) + (size_t)l * WT_LAYER;
  const bf16_t* U = (const bf16_t*)(p.ws + OFF_U);
  const bf16_t* Y = (const bf16_t*)(p.ws + OFF_Y);
  bf16_t* MG = (bf16_t*)(p.ws + OFF_MERGED);
  const int tid_ = TIDX, lane = tid_ & 63, wave = tid_ >> 6, wm = wave >> 1, wn = wave & 1;
  const int nt = (G.TG / 128) * 16;
  for (int t = bid; t < nt; t += nblk) {
    int m0 = (t >> 4) * 128, n0 = (t & 15) * 64;
    f32x4 tot[4][2];
#pragma unroll
    for (int i = 0; i < 4; i++)
#pragma unroll
      for (int j = 0; j < 2; j++) tot[i][j] = (f32x4){0.f, 0.f, 0.f, 0.f};
#pragma unroll 1
    for (int bch = 0; bch < 4; bch++) {
      f32x4 acc[4][2];
#pragma unroll
      for (int i = 0; i < 4; i++)
#pragma unroll
        for (int j = 0; j < 2; j++) acc[i][j] = (f32x4){0.f, 0.f, 0.f, 0.f};
      gemm_core<2>(acc, Y + (size_t)m0 * 2048 + bch * 512, 2048, WT + W_OA + (size_t)bch * 524288 + (size_t)n0 * 512, 512, 512, smem);
#pragma unroll
      for (int i = 0; i < 4; i++)
#pragma unroll
        for (int j = 0; j < 2; j++) {
          int row = m0 + wm * 64 + i * 16 + (lane & 15), col = n0 + wn * 32 + j * 16 + (lane >> 4) * 4;
          const unsigned* gp = (const unsigned*)(U + (size_t)row * DIN + 4656 + bch * 1024 + col);
          unsigned g0 = gp[0], g1 = gp[1];
          tot[i][j][0] += lo16(g0) * acc[i][j][0]; tot[i][j][1] += hi16(g0) * acc[i][j][1];
          tot[i][j][2] += lo16(g1) * acc[i][j][2]; tot[i][j][3] += hi16(g1) * acc[i][j][3];
        }
    }
#pragma unroll
    for (int i = 0; i < 4; i++)
#pragma unroll
      for (int j = 0; j < 2; j++) {
        int row = m0 + wm * 64 + i * 16 + (lane & 15), col = n0 + wn * 32 + j * 16 + (lane >> 4) * 4;
        *(uint2*)(MG + (size_t)row * 1024 + col) = pack4(tot[i][j][0], tot[i][j][1], tot[i][j][2], tot[i][j][3]);
      }
  }
}

DEVI void phase_wout(const Params& p, int l, const Grp& G, int bid, int nblk, char* smem) {
  const bf16_t* WT = (const bf16_t*)(p.ws + OFF_WT) + (size_t)l * WT_LAYER;
  const bf16_t* MG = (const bf16_t*)(p.ws + OFF_MERGED);
  const float* mod = (const float*)(p.ws + OFF_MOD);
  int rot = 0;
  gemm_tiles(MG, 1024, WT + W_OUT, 1024, G.TG, 1024, 1024, rot, bid, nblk, smem, [&](int row, int col, f32x4 v) {
    int gt = G.tok0 + row;
    const float* x;
    if (l == 0) x = (gt < 4096) ? p.in[0] + (size_t)gt * 1024 : p.in[1] + (size_t)(gt - 4096) * 1024;
    else x = p.out + (size_t)gt * 1024;
    int j = G.sample ? 1 + G.batch0 + row / 4096 : 0;
    float4 g1 = *(const float4*)(mod + (size_t)(l * 9 + j) * 6144 + 2048 + col);
    float4 xv = *(const float4*)(x + col);
    *(float4*)(p.out + (size_t)gt * 1024 + col) = make_float4(xv.x + g1.x * v[0], xv.y + g1.y * v[1], xv.z + g1.z * v[2], xv.w + g1.w * v[3]);
  });
}
DEVI void phase_mlp1(const Params& p, int l, const Grp& G, int bid, int nblk, char* smem) {
  const bf16_t* WT = (const bf16_t*)(p.ws + OFF_WT) + (size_t)l * WT_LAYER;
  const bf16_t* H = (const bf16_t*)(p.ws + OFF_H);
  bf16_t* HID = (bf16_t*)(p.ws + OFF_U);
  int rot = 0;
  gemm_tiles(H, 1024, WT + W_M1, 1024, G.TG, 4096, 1024, rot, bid, nblk, smem, [&](int row, int col, f32x4 v) {
    float a = fmaxf(v[0], 0.f), b = fmaxf(v[1], 0.f), c = fmaxf(v[2], 0.f), d = fmaxf(v[3], 0.f);
    *(uint2*)(HID + (size_t)row * 4096 + col) = pack4(a * a, b * b, c * c, d * d);
  });
}
DEVI void phase_mlp2(const Params& p, int l, const Grp& G, int bid, int nblk, char* smem) {
  const bf16_t* WT = (const bf16_t*)(p.ws + OFF_WT) + (size_t)l * WT_LAYER;
  const bf16_t* HID = (const bf16_t*)(p.ws + OFF_U);
  const float* mod = (const float*)(p.ws + OFF_MOD);
  int rot = 0;
  gemm_tiles(HID, 4096, WT + W_M2, 4096, G.TG, 1024, 4096, rot, bid, nblk, smem, [&](int row, int col, f32x4 v) {
    int gt = G.tok0 + row;
    int j = G.sample ? 1 + G.batch0 + row / 4096 : 0;
    float4 g2 = *(const float4*)(mod + (size_t)(l * 9 + j) * 6144 + 5120 + col);
    float* x = p.out + (size_t)gt * 1024 + col;
    float4 xv = *(const float4*)x;
    *(float4*)x = make_float4(xv.x + g2.x * v[0], xv.y + g2.y * v[1], xv.z + g2.z * v[2], xv.w + g2.w * v[3]);
  });
}


#define XB_TMO      128
#define XB_XCNT(j)  (256  + 64 * (j))
#define XB_XSUB(j)  (1280 + 64 * (j))
#define XB_XGEN(j)  (2304 + 64 * (j))
#define XB_TOP      3328
#define XB_TOPGEN   3392
#define XCD_BAR_WORDS 3456
#define XB_SPIN_CAP (1u << 22)
#define LAS __attribute__((address_space(3)))
DEVI unsigned xb_ld(unsigned* p) { return __hip_atomic_load(p, __ATOMIC_RELAXED, __HIP_MEMORY_SCOPE_AGENT); }
DEVI unsigned xb_add(unsigned* p, unsigned v) { return __hip_atomic_fetch_add(p, v, __ATOMIC_RELAXED, __HIP_MEMORY_SCOPE_AGENT); }
DEVI unsigned xb_xcc_id() { return (unsigned)__builtin_amdgcn_s_getreg((3 << 11) | 20) & 0xFu; }
#define XB_SPIN(cond, bar) do { unsigned _sp = 0; while (cond) { __builtin_amdgcn_s_sleep(1); \
    if ((++_sp & 255u) == 0u) { if (xb_ld(&(bar)[XB_TMO])) break; if (_sp > XB_SPIN_CAP) { atomicAdd(&(bar)[XB_TMO], 1u); break; } } } } while (0)
struct XcdBarrier { unsigned* bar; unsigned x; volatile LAS unsigned* st; };
DEVI XcdBarrier xcd_barrier_post(unsigned* bar, volatile LAS unsigned* st) {
  XcdBarrier b; b.bar = bar; b.x = xb_xcc_id(); b.st = st;
  if (__builtin_amdgcn_workitem_id_x() == 0) (void)xb_add(&bar[XB_XCNT(b.x)], 1u);
  return b;
}
DEVI void xcd_barrier_complete(unsigned* bar, unsigned x, unsigned& nloc, unsigned& nx) {
  const unsigned G = gridDim.x;
  unsigned sum, cnt, mine, sp = 0u;
  for (;;) {
    sum = 0u; cnt = 0u; mine = 0u;
#pragma unroll
    for (unsigned j = 0; j < 16; ++j) { const unsigned c = xb_ld(&bar[XB_XCNT(j)]); sum += c; cnt += (c > 0u) ? 1u : 0u; mine = (j == x) ? c : mine; }
    if (sum == G) break;
    __builtin_amdgcn_s_sleep(1);
    if ((++sp & 255u) == 0u) { if (xb_ld(&bar[XB_TMO])) break; if (sp > XB_SPIN_CAP) { atomicAdd(&bar[XB_TMO], 1u); break; } }
  }
  nloc = mine > 0u ? mine : 1u; nx = cnt > 0u ? cnt : 1u;
}
DEVI void xcd_barrier(const XcdBarrier& b) {
  asm volatile("s_waitcnt vmcnt(0)" ::: "memory");
  __syncthreads();
  if (__builtin_amdgcn_workitem_id_x() == 0) {
    unsigned* bar = b.bar;
    __builtin_amdgcn_s_waitcnt(0);
    unsigned nloc = b.st[0], nx = b.st[1];
    if (nloc == 0u) { xcd_barrier_complete(bar, b.x, nloc, nx); b.st[0] = nloc; b.st[1] = nx; }
    const unsigned old = xb_add(&bar[XB_XSUB(b.x)], 1u);
    const unsigned gen = old / nloc;
    if (old + 1u == (gen + 1u) * nloc) {
      __builtin_amdgcn_fence(__ATOMIC_RELEASE, "agent");
      asm volatile("s_waitcnt vmcnt(0)" ::: "memory");
      const unsigned og = xb_add(&bar[XB_TOP], 1u);
      const unsigned tg = og / nx;
      if (og + 1u == (tg + 1u) * nx) xb_add(&bar[XB_TOPGEN], 1u);
      else XB_SPIN(xb_ld(&bar[XB_TOPGEN]) == tg, bar);
      __builtin_amdgcn_fence(__ATOMIC_ACQUIRE, "agent");
      xb_add(&bar[XB_XGEN(b.x)], 1u);
      asm volatile("s_waitcnt vmcnt(0)" ::: "memory");
    } else {
      XB_SPIN(xb_ld(&bar[XB_XGEN(b.x)]) == gen, bar);
      __builtin_amdgcn_fence(__ATOMIC_ACQUIRE, "agent");
      asm volatile("s_waitcnt vmcnt(0)" ::: "memory");
    }
  }
  __syncthreads();
}

DEVI void flat_barrier(unsigned* cnt, unsigned target) {
  asm volatile("s_waitcnt vmcnt(0)" ::: "memory");
  __syncthreads();
  if (__builtin_amdgcn_workitem_id_x() == 0) {
    __builtin_amdgcn_fence(__ATOMIC_RELEASE, "agent");
    asm volatile("s_waitcnt vmcnt(0)" ::: "memory");
    xb_add(cnt, 1u);
    unsigned sp = 0;
    while (xb_ld(cnt) < target) { __builtin_amdgcn_s_sleep(1); if (++sp > (1u << 24)) break; }
    __builtin_amdgcn_fence(__ATOMIC_ACQUIRE, "agent");
    asm volatile("s_waitcnt vmcnt(0)" ::: "memory");
  }
  __syncthreads();
}

enum { PH_PRE = 0, PH_GEMM_IN, PH_PREPA, PH_GEMM_SMALL, PH_PREPB, PH_MIX, PH_POST, PH_MERGE, PH_WOUT, PH_PRE2, PH_MLP1, PH_MLP2, PH_COUNT };

DEVI void run_phase(const Params& p, int ph, int l, int g, int bid, int nblk, char* smem, int* s_item, int rep = 0) {
#ifndef SKIPMASK
#define SKIPMASK 0
#endif
#ifndef CASEMASK
#define CASEMASK 4095
#endif
  Grp G = get_grp(g);
  if ((SKIPMASK >> ph) & 1) return;
  switch (ph) {
    case PH_PRE: if (CASEMASK & 1) { phase_pre(p, l, G, 0, bid, nblk); } break;
    case PH_GEMM_IN: if (CASEMASK & 2) { phase_gemm_in(p, l, G, bid, nblk, smem); } break;
    case PH_PREPA: if (CASEMASK & 4) { phase_prepa(p, l, G, bid, nblk); } break;
    case PH_GEMM_SMALL: if (CASEMASK & 8) { phase_gemm_small(p, l, G, bid, nblk, smem); } break;
    case PH_PREPB: if (CASEMASK & 16) { phase_prepb(p, l, G, bid, nblk); } break;
    case PH_MIX: if (CASEMASK & 32) { phase_mix(p, l, g, G, smem, s_item, rep * 16); } break;
    case PH_POST: if (CASEMASK & 64) { phase_post(p, l, G, bid, nblk); } break;
    case PH_MERGE: if (CASEMASK & 128) { phase_merge(p, l, G, bid, nblk, smem); } break;
    case PH_WOUT: if (CASEMASK & 256) { phase_wout(p, l, G, bid, nblk, smem); } break;
    case PH_PRE2: if (CASEMASK & 512) { phase_pre(p, l, G, 1, bid, nblk); } break;
    case PH_MLP1: if (CASEMASK & 1024) { phase_mlp1(p, l, G, bid, nblk, smem); } break;
    case PH_MLP2: if (CASEMASK & 2048) { phase_mlp2(p, l, G, bid, nblk, smem); } break;
    default: break;
  }
}

#if MEGA
__global__ void __launch_bounds__(NTHREADS, 2) k_mega(Params p) {
  __shared__ __attribute__((aligned(16))) char smem[SMEM_BYTES];
  __shared__ int s_item;
  cg::grid_group grid = cg::this_grid();
  __shared__ uint4 xb_words;
  const int bid = blockIdx.x, nblk = gridDim.x;
  if (__builtin_amdgcn_workitem_id_x() == 0) xb_words = make_uint4(0u, 0u, 0u, 0u);
  phase_init(p, bid, nblk, smem);
  grid.sync();
  XcdBarrier xb = xcd_barrier_post((unsigned*)(p.ws + OFF_BAR), (volatile LAS unsigned*)&xb_words);
  unsigned* sb_cnt = (unsigned*)(p.ws + OFF_BAR) + 3520;
  unsigned sb_epoch = 0;
#pragma unroll 1
  for (int l = 0; l < 2; l++)
#pragma unroll 1
    for (int g = 0; g < 5; g++)
#pragma unroll 1
      for (int ph = 0; ph < PH_COUNT; ph++) {
        if (g > 0) {
          if (ph == PH_GEMM_SMALL || ph == PH_PREPB) continue;
          if (ph == PH_GEMM_IN) {
            Grp G = get_grp(g);
            phase_gemm_in(p, l, G, bid, nblk, smem, 1);
            xcd_barrier(xb);
            continue;
          }
          if (ph == PH_PREPA) {
            Grp G = get_grp(g);
            phase_prepa(p, l, G, bid, nblk);
            phase_gemm_small(p, l, G, bid, nblk, smem, 2);
            xcd_barrier(xb);
            continue;
          }
          if (ph == PH_MIX) {
            Grp G = get_grp(g);
            int* ctr = (int*)(p.ws + OFF_CTR2) + (l * 5 + g) * 32;
            const int n_rw = G.NS * 128, n_chain = n_rw + G.NS * 8;
            if (bid < n_chain) {
              chain_item(p, l, G, bid, n_rw, smem);
            } else {
              const int wid = bid - n_chain, nw = nblk - n_chain;
              phase_gemm_small(p, l, G, wid, nw, smem, 1);
              sb_epoch++; flat_barrier(sb_cnt, sb_epoch * (unsigned)nw);
              phase_prepb(p, l, G, wid, nw);
              sb_epoch++; flat_barrier(sb_cnt, sb_epoch * (unsigned)nw);
              if (__builtin_amdgcn_workitem_id_x() == 0) xb_add((unsigned*)ctr + 30, 1u);
            }
            if (bid < n_chain) {
              if (__builtin_amdgcn_workitem_id_x() == 0) {
                unsigned sp = 0;
                while (xb_ld((unsigned*)ctr + 30) < (unsigned)(nblk - n_chain)) { __builtin_amdgcn_s_sleep(2); if (++sp > (1u << 24)) break; }
                __builtin_amdgcn_fence(__ATOMIC_ACQUIRE, "agent");
                asm volatile("s_waitcnt vmcnt(0)" ::: "memory");
              }
              __syncthreads();
            }
            attn_queues(p, l, G, smem, &s_item, ctr);
            if (bid >= n_chain) phase_gemm_in(p, l, G, bid - n_chain, nblk - n_chain, smem, 2);
            xcd_barrier(xb);
            continue;
          }
        }
        run_phase(p, ph, l, g, bid, nblk, smem, &s_item);
        if (!(ph == PH_MLP2 && !(l == 1 && g == 4))) { xcd_barrier(xb); }
      }
}
#else
template <int PH>
__global__ void __launch_bounds__(NTHREADS, 2) k_phase(Params p, int l, int g) {
  __shared__ __attribute__((aligned(16))) char smem[SMEM_BYTES];
  __shared__ int s_item;
  const int bid = blockIdx.x, nblk = gridDim.x;
  if (PH < 0) phase_init(p, bid, nblk, smem);
  else run_phase(p, PH, l, g, bid, nblk, smem, &s_item);
}
template <int PH> void launch_phase(const Params& p, int l, int g, hipStream_t stream) {
  k_phase<PH><<<512, NTHREADS, 0, stream>>>(p, l, g);
}

#endif

extern "C" void kernel_launch(void* const* d_in, const int* in_sizes, int n_in, void* d_out, int out_size, void* d_ws, size_t ws_size,
                              hipStream_t stream) {
  Params p{};
  for (int i = 0; i < 46; i++) p.in[i] = (const float*)d_in[i];
  p.out = (float*)d_out;
  p.ws = (char*)d_ws;
  if (ws_size < WS_TOTAL) { fprintf(stderr, "workspace too small: %zu < %zu\n", ws_size, (size_t)WS_TOTAL); return; }
#if MEGA
  static int grid_blocks = 0;
  if (!grid_blocks) {
    int dev = 0, cus = 0, per_cu = 0;
    hipGetDevice(&dev);
    hipDeviceGetAttribute(&cus, hipDeviceAttributeMultiprocessorCount, dev);
    hipOccupancyMaxActiveBlocksPerMultiprocessor(&per_cu, k_mega, NTHREADS, 0);
    per_cu = 2;
    grid_blocks = cus * per_cu;
  }
  void* args[] = {&p};
  hipError_t e = hipLaunchCooperativeKernel((void*)k_mega, dim3(grid_blocks), dim3(NTHREADS), args, 0, stream);
  if (e != hipSuccess) fprintf(stderr, "cooperative launch failed: %s (grid %d)\n", hipGetErrorString(e), grid_blocks);
#else
  launch_phase<-1>(p, 0, 0, stream);
  for (int l = 0; l < 2; l++)
    for (int g = 0; g < 5; g++) {
      launch_phase<0>(p, l, g, stream); launch_phase<1>(p, l, g, stream); launch_phase<2>(p, l, g, stream); launch_phase<3>(p, l, g, stream);
      launch_phase<4>(p, l, g, stream); launch_phase<5>(p, l, g, stream); launch_phase<6>(p, l, g, stream); launch_phase<7>(p, l, g, stream);
      launch_phase<8>(p, l, g, stream); launch_phase<9>(p, l, g, stream); launch_phase<10>(p, l, g, stream); launch_phase<11>(p, l, g, stream);
    }
#endif
}
```

```cpp
#include <hip/hip_runtime.h>
#include <hip/hip_bf16.h>
#include <hip/hip_cooperative_groups.h>
#include <cstdio>
namespace cg = cooperative_groups;

#ifndef MEGA
#define MEGA 1
#endif

typedef unsigned short bf16_t;
typedef short bf16x8 __attribute__((ext_vector_type(8)));
typedef float f32x4 __attribute__((ext_vector_type(4)));
typedef unsigned u32x4 __attribute__((ext_vector_type(4)));
#define DEVI __device__ __forceinline__

constexpr int DIN = 8752;
constexpr int NTHREADS = 256;
constexpr int SMEM_BYTES = 80000;

constexpr size_t WT_LAYER = 21102592;
constexpr size_t W_IN = 0, W_UQ = 9043968, W_UKV = 9240576, W_OA = 9371648, W_OB = 9895936, W_OC = 10420224, W_OD = 10944512;
constexpr size_t W_W2 = 11468800  , W_A2 = 11534336  , W_G2 = 11599872, W_OUT = 11665408, W_M1 = 12713984, W_M2 = 16908288;

constexpr size_t OFF_WT = 0;
constexpr size_t OFF_MOD = 84410368;
constexpr size_t OFF_CTR = OFF_MOD + 442368;
constexpr size_t OFF_H = OFF_CTR + 256;
constexpr size_t OFF_U = OFF_H + 16777216;
constexpr size_t OFF_LIF = OFF_U + 143392768;
constexpr size_t OFF_CKV = OFF_LIF + 524288;
constexpr size_t OFF_KROPE = OFF_CKV + 2228224;
constexpr size_t OFF_Q = OFF_KROPE + 1114112;
constexpr size_t OFF_KNOPE = OFF_Q + 12582912;
constexpr size_t OFF_K = OFF_KNOPE + 8912896;
constexpr size_t OFF_VT = OFF_K + 13369344;
constexpr size_t OFF_QS = OFF_VT + 8912896;
constexpr size_t OFF_KS = OFF_QS + 8388608;
constexpr size_t OFF_VTS = OFF_KS + 2228224;
constexpr size_t OFF_WA = OFF_VTS + 2228224;
constexpr size_t OFF_G = OFF_WA + 33554432;
constexpr size_t OFF_YRW = OFF_G + 8388608;
constexpr size_t OFF_HML = OFF_YRW + 33554432;
constexpr size_t OFF_Y = OFF_HML + 33554432;
constexpr size_t OFF_MERGED = OFF_Y + 33554432;
constexpr size_t OFF_CTR2 = OFF_MERGED + 16777216;
constexpr size_t OFF_BAR = OFF_CTR2 + 4096;
constexpr size_t WS_TOTAL = OFF_BAR + 16384;

constexpr size_t O_YP = 0, O_YS = 4194304, O_CKV = 37748736, O_KROPE = 38797312, O_SWAK = 39059456, O_SWAV = 40108032;
constexpr size_t O_MLC = 41156608, O_MLN = 43253760, O_MLM = 43270144, O_RW = 43270400;

struct Params {
  const float* in[46];
  float* out;
  char* ws;
};

struct Grp { int tok0, NS, S, CTX, sample, batch0, TG, KS, NK; };
DEVI Grp get_grp(int g) {
  Grp G;
  if (g == 0) { G.tok0 = 0; G.NS = 16; G.S = 256; G.CTX = 0; G.sample = 0; G.batch0 = 0; G.TG = 4096; G.KS = 256; G.NK = 4096; }
  else { G.tok0 = 4096 + (g - 1) * 8192; G.NS = 2; G.S = 4096; G.CTX = 256; G.sample = 1; G.batch0 = (g - 1) * 2; G.TG = 8192; G.KS = 4352; G.NK = 8704; }
  return G;
}

DEVI bf16_t f2bf(float f) { unsigned u = __float_as_uint(f); u += 0x7fffu + ((u >> 16) & 1u); return (bf16_t)(u >> 16); }
DEVI float bf2f(bf16_t h) { return __uint_as_float(((unsigned)h) << 16); }
DEVI unsigned pack2(float a, float b) { unsigned r; asm("s_nop 1\n\tv_cvt_pk_bf16_f32 %0, %1, %2" : "=v"(r) : "v"(a), "v"(b)); return r; }
DEVI uint2 pack4(float a, float b, float c, float d) { uint2 r; r.x = pack2(a, b); r.y = pack2(c, d); return r; }
DEVI float lo16(unsigned u) { return __uint_as_float(u << 16); }
DEVI float hi16(unsigned u) { return __uint_as_float(u & 0xffff0000u); }
DEVI int opaque(int x) { asm volatile("" : "+v"(x)); return x; }
#define TIDX (opaque((int)__builtin_amdgcn_workitem_id_x()))
DEVI float sigm(float x) { return __builtin_amdgcn_rcpf(1.f + __expf(-x)); }
DEVI float wave_sum(float v) {
#pragma unroll
  for (int o = 32; o > 0; o >>= 1) v += __shfl_xor(v, o);
  return v;
}
template <int CTRL> DEVI float dpp_add(float x) {
  return x + __builtin_bit_cast(float, __builtin_amdgcn_update_dpp(0, __builtin_bit_cast(int, x), CTRL, 0xf, 0xf, false));
}
DEVI float row16_sum(float x) {
  x = dpp_add<0xB1>(x); x = dpp_add<0x4E>(x); x = dpp_add<0x141>(x); x = dpp_add<0x128>(x);
  return x;
}
DEVI f32x4 mma(bf16x8 arow, bf16x8 bcol, f32x4 c) { return __builtin_amdgcn_mfma_f32_16x16x32_bf16(bcol, arow, c, 0, 0, 0); }
DEVI bf16x8 ldfrag_l(const bf16_t* base, int stride, int row0, int k0, int lane) {
  return *(const bf16x8*)(base + (row0 + (lane & 15)) * stride + k0 + (lane >> 4) * 8);
}
DEVI bf16x8 ldfrag(const bf16_t* base, int stride, int row0, int k0) {
  int lane = TIDX & 63;
  return *(const bf16x8*)(base + (row0 + (lane & 15)) * stride + k0 + (lane >> 4) * 8);
}

DEVI void conv_T(const float* __restrict__ src, bf16_t* __restrict__ dst, int K, int N, int Npad, int& rot, int bid, int nblk, float* sm) {
  const int tid = TIDX;
  const int tk = K / 64, tn = Npad / 64, nt = tk * tn;
  int first = (bid + nblk - (rot % nblk)) % nblk;
  for (int t = first; t < nt; t += nblk) {
    int k0 = (t / tn) * 64, n0 = (t % tn) * 64;
    __syncthreads();
#pragma unroll 4
    for (int i = 0; i < 16; i++) {
      int r = i * 4 + (tid >> 6), c = tid & 63, n = n0 + c;
      sm[r * 65 + c] = (n < N) ? src[(size_t)(k0 + r) * N + n] : 0.f;
    }
    __syncthreads();
#pragma unroll 4
    for (int i = 0; i < 16; i++) {
      int r = i * 4 + (tid >> 6), c = tid & 63;
      dst[(size_t)(n0 + r) * K + k0 + c] = f2bf(sm[c * 65 + r]);
    }
  }
  rot += nt;
}

DEVI void phase_init(const Params& p, int bid, int nblk, char* smem) {
  const int tid = TIDX;
  if (bid == 0) for (int i = tid; i < 1024 + 4096; i += NTHREADS) ((int*)(p.ws + OFF_CTR2))[i] = 0;
  bf16_t* WT = (bf16_t*)(p.ws + OFF_WT);
  float* sm = (float*)smem;
  int rot = 0;
  for (int l = 0; l < 2; l++) {
    bf16_t* w = WT + (size_t)l * WT_LAYER;
    conv_T(p.in[16] + (size_t)l * 1024 * DIN, w + W_IN, 1024, DIN, 8832, rot, bid, nblk, sm);
    conv_T(p.in[44] + (size_t)l * 1024 * 4096, w + W_M1, 1024, 4096, 4096, rot, bid, nblk, sm);
    conv_T(p.in[45] + (size_t)l * 4096 * 1024, w + W_M2, 4096, 1024, 1024, rot, bid, nblk, sm);
    conv_T(p.in[43] + (size_t)l * 1024 * 1024, w + W_OUT, 1024, 1024, 1024, rot, bid, nblk, sm);
    conv_T(p.in[23] + (size_t)l * 512 * 1024, w + W_OA, 512, 1024, 1024, rot, bid, nblk, sm);
    conv_T(p.in[27] + (size_t)l * 512 * 1024, w + W_OB, 512, 1024, 1024, rot, bid, nblk, sm);
    conv_T(p.in[31] + (size_t)l * 512 * 1024, w + W_OC, 512, 1024, 1024, rot, bid, nblk, sm);
    conv_T(p.in[42] + (size_t)l * 512 * 1024, w + W_OD, 512, 1024, 1024, rot, bid, nblk, sm);
    conv_T(p.in[19] + (size_t)l * 256 * 768, w + W_UQ, 256, 768, 768, rot, bid, nblk, sm);
    conv_T(p.in[20] + (size_t)l * 128 * 1024, w + W_UKV, 128, 1024, 1024, rot, bid, nblk, sm);
    for (int d = 0; d < 2; d++) {
      conv_T(p.in[33] + (size_t)(l * 2 + d) * 64 * 512, w + W_W2 + d * 32768, 64, 512, 512, rot, bid, nblk, sm);
      conv_T(p.in[35] + (size_t)(l * 2 + d) * 64 * 512, w + W_A2 + d * 32768, 64, 512, 512, rot, bid, nblk, sm);
    }
    conv_T(p.in[36] + (size_t)l * 128 * 512, w + W_G2, 128, 512, 512, rot, bid, nblk, sm);
  }
  __syncthreads();
  float* sc = (float*)smem;
  float* red = sc + 9216;
  float* mod = (float*)(p.ws + OFF_MOD);
  bool any = false;
  for (int job = nblk - 1 - bid; job < 192; job += nblk) {
    if (!any) {
      for (int i = tid; i < 9216; i += NTHREADS) {
        int j = i >> 10, k = i & 1023;
        float c = (j == 0) ? p.in[11][k] : p.in[2][(j - 1) * 1024 + k];
        sc[i] = c / (1.f + __expf(-c));
      }
      any = true;
    }
    __syncthreads();
    int l = job / 96, n0 = (job % 96) * 64, kg = tid >> 6, cl = tid & 63, col = n0 + cl;
    float acc[9];
#pragma unroll
    for (int j = 0; j < 9; j++) acc[j] = 0.f;
    const float* w = p.in[12] + (size_t)l * 1024 * 6144 + col;
    for (int k = kg * 256; k < kg * 256 + 256; k++) {
      float wv = w[(size_t)k * 6144];
#pragma unroll
      for (int j = 0; j < 9; j++) acc[j] += sc[j * 1024 + k] * wv;
    }
#pragma unroll
    for (int j = 0; j < 9; j++) red[(kg * 9 + j) * 64 + cl] = acc[j];
    __syncthreads();
    if (kg == 0) {
      float bb = p.in[13][l * 6144 + col];
#pragma unroll
      for (int j = 0; j < 9; j++)
        mod[(size_t)(l * 9 + j) * 6144 + col] = red[j * 64 + cl] + red[(9 + j) * 64 + cl] + red[(18 + j) * 64 + cl] + red[(27 + j) * 64 + cl] + bb;
    }
  }
}

DEVI void phase_pre(const Params& p, int l, const Grp& G, int which, int bid, int nblk) {
  const float* nw = p.in[which ? 15 : 14] + l * 1024;
  const float* mod = (const float*)(p.ws + OFF_MOD);
  bf16_t* H = (bf16_t*)(p.ws + OFF_H);
  const int tid_ = TIDX, lane = tid_ & 63, wv = tid_ >> 6;
  const int stride = nblk * 4;
  for (int t0 = bid * 4 + wv; t0 < G.TG; t0 += 2 * stride) {
    const int t1 = t0 + stride;
    const bool has1 = t1 < G.TG;
    const float* x[2];
    int tt[2] = {t0, has1 ? t1 : t0};
#pragma unroll
    for (int u = 0; u < 2; u++) {
      int gt = G.tok0 + tt[u];
      if (which == 0 && l == 0) x[u] = (gt < 4096) ? p.in[0] + (size_t)gt * 1024 : p.in[1] + (size_t)(gt - 4096) * 1024;
      else x[u] = p.out + (size_t)gt * 1024;
    }
    float4 v[2][4];
#pragma unroll
    for (int u = 0; u < 2; u++)
#pragma unroll
      for (int i = 0; i < 4; i++) v[u][i] = *(const float4*)(x[u] + i * 256 + lane * 4);
#pragma unroll
    for (int u = 0; u < 2; u++) {
      if (u == 1 && !has1) break;
      const int t = tt[u];
      int j = G.sample ? 1 + G.batch0 + t / 4096 : 0;
      const float* md = mod + (size_t)(l * 9 + j) * 6144 + (which ? 3072 : 0);
      float ss = 0.f;
#pragma unroll
      for (int i = 0; i < 4; i++) ss += v[u][i].x * v[u][i].x + v[u][i].y * v[u][i].y + v[u][i].z * v[u][i].z + v[u][i].w * v[u][i].w;
      ss = wave_sum(ss);
      float rs = rsqrtf(ss * (1.f / 1024.f) + 1e-6f);
#pragma unroll
      for (int i = 0; i < 4; i++) {
        int c = i * 256 + lane * 4;
        float4 g = *(const float4*)(nw + c), sh = *(const float4*)(md + c), sc = *(const float4*)(md + 1024 + c);
        float o0 = v[u][i].x * rs * g.x * (1.f + sc.x) + sh.x;
        float o1 = v[u][i].y * rs * g.y * (1.f + sc.y) + sh.y;
        float o2 = v[u][i].z * rs * g.z * (1.f + sc.z) + sh.z;
        float o3 = v[u][i].w * rs * g.w * (1.f + sc.w) + sh.w;
        *(uint2*)(H + (size_t)t * 1024 + c) = pack4(o0, o1, o2, o3);
      }
    }
  }
}

DEVI void mfma_settle(f32x4 (&a)[4][4]) {
  asm volatile("s_nop 15\n\ts_nop 15\n\ts_nop 7"
               : "+v"(a[0][0]), "+v"(a[0][1]), "+v"(a[0][2]), "+v"(a[0][3]), "+v"(a[1][0]), "+v"(a[1][1]), "+v"(a[1][2]), "+v"(a[1][3]),
                 "+v"(a[2][0]), "+v"(a[2][1]), "+v"(a[2][2]), "+v"(a[2][3]), "+v"(a[3][0]), "+v"(a[3][1]), "+v"(a[3][2]), "+v"(a[3][3]));
}
DEVI void mfma_settle(f32x4 (&a)[4][2]) {
  asm volatile("s_nop 15\n\ts_nop 15\n\ts_nop 7"
               : "+v"(a[0][0]), "+v"(a[0][1]), "+v"(a[1][0]), "+v"(a[1][1]), "+v"(a[2][0]), "+v"(a[2][1]), "+v"(a[3][0]), "+v"(a[3][1]));
}
DEVI void mfma_settle9(f32x4 (&a)[9]) {
  asm volatile("s_nop 15\n\ts_nop 15\n\ts_nop 7"
               : "+v"(a[0]), "+v"(a[1]), "+v"(a[2]), "+v"(a[3]), "+v"(a[4]), "+v"(a[5]), "+v"(a[6]), "+v"(a[7]), "+v"(a[8]));
}

constexpr int LDT = 72;
template <int NJ>
DEVI void gemm_core(f32x4 (&acc)[4][NJ], const bf16_t* __restrict__ A, int lda, const bf16_t* __restrict__ B, int ldb, int K, char* smem) {
  constexpr int BUFE = 256 * LDT;
  bf16_t* sbase = (bf16_t*)smem;
  const int tid = TIDX, lane = tid & 63, wave = tid >> 6, wm = wave >> 1, wn = wave & 1;
  u32x4 ra[4], rb[NJ];
#pragma unroll
  for (int i = 0; i < 4; i++) {
    int id = tid + i * 256, r = id >> 3, ck = id & 7;
    ra[i] = *(const u32x4*)(A + (size_t)r * lda + ck * 8);
    if (i < NJ) rb[i] = *(const u32x4*)(B + (size_t)r * ldb + ck * 8);
  }
  __syncthreads();
#pragma unroll
  for (int i = 0; i < 4; i++) {
    int id = tid + i * 256, r = id >> 3, ck = id & 7;
    *(u32x4*)(sbase + r * LDT + ck * 8) = ra[i];
    if (i < NJ) *(u32x4*)(sbase + 128 * LDT + r * LDT + ck * 8) = rb[i];
  }
  if (64 < K) {
#pragma unroll
    for (int i = 0; i < 4; i++) {
      int id = tid + i * 256, r = id >> 3, ck = id & 7;
      ra[i] = *(const u32x4*)(A + (size_t)r * lda + 64 + ck * 8);
      if (i < NJ) rb[i] = *(const u32x4*)(B + (size_t)r * ldb + 64 + ck * 8);
    }
  }
  __syncthreads();
  int cur = 0;
#pragma unroll 1
  for (int k0 = 0; k0 < K; k0 += 64) {
    bf16_t* sA = sbase + cur * BUFE;
    bf16_t* sB = sA + 128 * LDT;
    if (k0 + 64 < K) {
      bf16_t* nA = sbase + (cur ^ 1) * BUFE;
      bf16_t* nB = nA + 128 * LDT;
#pragma unroll
      for (int i = 0; i < 4; i++) {
        int id = tid + i * 256, r = id >> 3, ck = id & 7;
        *(u32x4*)(nA + r * LDT + ck * 8) = ra[i];
        if (i < NJ) *(u32x4*)(nB + r * LDT + ck * 8) = rb[i];
      }
      if (k0 + 128 < K) {
#pragma unroll
        for (int i = 0; i < 4; i++) {
          int id = tid + i * 256, r = id >> 3, ck = id & 7;
          ra[i] = *(const u32x4*)(A + (size_t)r * lda + k0 + 128 + ck * 8);
          if (i < NJ) rb[i] = *(const u32x4*)(B + (size_t)r * ldb + k0 + 128 + ck * 8);
        }
      }
    }
#pragma unroll
    for (int kk = 0; kk < 2; kk++) {
      bf16x8 af[4], bf[NJ];
#pragma unroll
      for (int i = 0; i < 4; i++) af[i] = ldfrag_l(sA, LDT, wm * 64 + i * 16, kk * 32, lane);
#pragma unroll
      for (int j = 0; j < NJ; j++) bf[j] = ldfrag_l(sB, LDT, wn * NJ * 16 + j * 16, kk * 32, lane);
#pragma unroll
      for (int i = 0; i < 4; i++)
#pragma unroll
        for (int j = 0; j < NJ; j++) acc[i][j] = mma(af[i], bf[j], acc[i][j]);
    }
    __syncthreads();
    cur ^= 1;
  }
  mfma_settle(acc);
}

template <class Epi>
DEVI void gemm_tiles(const bf16_t* A, int lda, const bf16_t* B, int ldb, int M, int N, int K, int& rot, int bid, int nblk, char* smem, Epi epi, bool xcd_map = false) {
  const int tm = M / 128, tn = N / 128, nt = tm * tn;
  const int tid_ = TIDX, lane = tid_ & 63, wave = tid_ >> 6, wm = wave >> 1, wn = wave & 1;
  if (xcd_map && (nblk & 7) == 0 && tn >= 8) {
    const int x = bid & 7, lb = bid >> 3, nl = nblk >> 3;
    const int cnt = (tn - x + 7) >> 3;
    for (int lt = lb; lt < tm * cnt; lt += nl) {
      int m0 = (lt / cnt) * 128, n0 = (x + 8 * (lt % cnt)) * 128;
      f32x4 acc[4][4];
#pragma unroll
      for (int i = 0; i < 4; i++)
#pragma unroll
        for (int j = 0; j < 4; j++) acc[i][j] = (f32x4){0.f, 0.f, 0.f, 0.f};
      gemm_core<4>(acc, A + (size_t)m0 * lda, lda, B + (size_t)n0 * ldb, ldb, K, smem);
#pragma unroll
      for (int i = 0; i < 4; i++)
#pragma unroll
        for (int j = 0; j < 4; j++) epi(m0 + wm * 64 + i * 16 + (lane & 15), n0 + wn * 64 + j * 16 + (lane >> 4) * 4, acc[i][j]);
    }
    rot += nt;
    return;
  }
  if (nt * 2 <= nblk) {
    const int tn2 = N / 64, nt2 = tm * tn2;
    for (int t = bid; t < nt2; t += nblk) {
      int m0 = (t / tn2) * 128, n0 = (t % tn2) * 64;
      f32x4 acc[4][2];
#pragma unroll
      for (int i = 0; i < 4; i++)
#pragma unroll
        for (int j = 0; j < 2; j++) acc[i][j] = (f32x4){0.f, 0.f, 0.f, 0.f};
      gemm_core<2>(acc, A + (size_t)m0 * lda, lda, B + (size_t)n0 * ldb, ldb, K, smem);
#pragma unroll
      for (int i = 0; i < 4; i++)
#pragma unroll
        for (int j = 0; j < 2; j++) epi(m0 + wm * 64 + i * 16 + (lane & 15), n0 + wn * 32 + j * 16 + (lane >> 4) * 4, acc[i][j]);
    }
    rot += nt;
    return;
  }
  int first = (bid + nblk - (rot % nblk)) % nblk;
  for (int t = first; t < nt; t += nblk) {
    int m0 = (t / tn) * 128, n0 = (t % tn) * 128;
    f32x4 acc[4][4];
#pragma unroll
    for (int i = 0; i < 4; i++)
#pragma unroll
      for (int j = 0; j < 4; j++) acc[i][j] = (f32x4){0.f, 0.f, 0.f, 0.f};
    gemm_core<4>(acc, A + (size_t)m0 * lda, lda, B + (size_t)n0 * ldb, ldb, K, smem);
#pragma unroll
    for (int i = 0; i < 4; i++)
#pragma unroll
      for (int j = 0; j < 4; j++) epi(m0 + wm * 64 + i * 16 + (lane & 15), n0 + wn * 64 + j * 16 + (lane >> 4) * 4, acc[i][j]);
  }
  rot += nt;
}

DEVI void phase_gemm_in(const Params& p, int l, const Grp& G, int bid, int nblk, char* smem, int part = 0) {
  const bf16_t* H = (const bf16_t*)(p.ws + OFF_H);
  const bf16_t* W = (const bf16_t*)(p.ws + OFF_WT) + (size_t)l * WT_LAYER + W_IN;
  bf16_t* U = (bf16_t*)(p.ws + OFF_U);
  float* lif = (float*)(p.ws + OFF_LIF);
  const float* ib = p.in[24] + l * 8;
  const float* fb = p.in[25] + l * 8;
  int rot = 0;
  const int nt0 = (part == 2) ? 45 : 0, ntn = (part == 0) ? 69 : (part == 1 ? 45 : 24);
  const int coff = nt0 * 128;
  gemm_tiles(H, 1024, W + (size_t)coff * 1024, 1024, G.TG, ntn * 128, 1024, rot, bid, nblk, smem, [&](int row, int col, f32x4 v) {
    col += coff;
    if (col >= DIN) return;
    if (col >= 4656) { for (int e = 0; e < 4; e++) v[e] = sigm(v[e]); }
    else if (col >= 1440 && col < 1456) {
      int j = col - 1440;
      for (int e = 0; e < 4; e++) {
        float x;
        if (j < 8) x = v[e] + ib[j + e];
        else { float z = v[e] + fb[j - 8 + e]; x = fminf(z, 0.f) - log1pf(__expf(-fabsf(z))); }
        lif[(size_t)row * 16 + j + e] = x;
      }
    }
    else if (col >= 416 && col < 672) { for (int e = 0; e < 4; e++) v[e] *= 0.125f; }
    else if (col >= 1456 && col < 1968) { for (int e = 0; e < 4; e++) v[e] = sigm(v[e]); }
    else if (col >= 4272 && col < 4400) { for (int e = 0; e < 4; e++) v[e] = tanhf(v[e]); }
    else if (col >= 4528 && col < 4656) { for (int e = 0; e < 4; e++) v[e] = sigm(v[e]); }
    *(uint2*)(U + (size_t)row * DIN + col) = pack4(v[0], v[1], v[2], v[3]);
  }, true);
}

DEVI void norm_rope64(float (&x)[8], const float* g, int j8, bool rope, float pr, float pc) {
  float ss = 0.f;
#pragma unroll
  for (int e = 0; e < 8; e++) ss += x[e] * x[e];
  ss += __shfl_xor(ss, 1); ss += __shfl_xor(ss, 2); ss += __shfl_xor(ss, 4);
  float rs = rsqrtf(ss * (1.f / 64.f) + 1e-6f);
#pragma unroll
  for (int e = 0; e < 8; e++) x[e] = x[e] * rs * g[j8 * 8 + e];
  if (rope) {
    float pos = (j8 < 4) ? pr : pc;
    int ib = (j8 & 1) * 8;
    bool second = (j8 & 2) != 0;
#pragma unroll
    for (int e = 0; e < 8; e++) {
      float other = __shfl_xor(x[e], 2);
      float ang = pos * exp2f(-(float)(ib + e) * 0.830482f);
      float c = __cosf(ang), s = __sinf(ang);
      x[e] = second ? x[e] * c + other * s : x[e] * c - other * s;
    }
  }
}
DEVI void unpack8(uint4 r, float (&x)[8]) {
  x[0] = lo16(r.x); x[1] = hi16(r.x); x[2] = lo16(r.y); x[3] = hi16(r.y);
  x[4] = lo16(r.z); x[5] = hi16(r.z); x[6] = lo16(r.w); x[7] = hi16(r.w);
}
DEVI uint4 pack8(const float (&x)[8]) {
  uint4 r; r.x = pack2(x[0], x[1]); r.y = pack2(x[2], x[3]); r.z = pack2(x[4], x[5]); r.w = pack2(x[6], x[7]); return r;
}

DEVI void phase_prepa(const Params& p, int l, const Grp& G, int bid, int nblk) {
  bf16_t* U = (bf16_t*)(p.ws + OFF_U);
  bf16_t* ckv = (bf16_t*)(p.ws + OFF_CKV);
  float* krope = (float*)(p.ws + OFF_KROPE);
  bf16_t* Qs = (bf16_t*)(p.ws + OFF_QS);
  bf16_t* Ks = (bf16_t*)(p.ws + OFF_KS);
  bf16_t* Vts = (bf16_t*)(p.ws + OFF_VTS);
  const int tid_ = TIDX, lane = tid_ & 63, wv = tid_ >> 6;
  const float* gq = p.in[17] + l * 256;
  const float* gkv = p.in[18] + l * 128;
  const float* gsq = p.in[28] + l * 64;
  const float* gsk = p.in[29] + l * 64;
  for (int t = bid * 4 + wv; t < G.TG; t += nblk * 4) {
    int sq = t / G.S, pos = t % G.S, key = sq * G.KS + pos;
    bf16_t* u = U + (size_t)t * DIN;
    size_t orow = (size_t)(sq * 2 + l) * 256 + pos;
    const uint2 raw_q = *(const uint2*)(u + lane * 4);
    const unsigned raw_kv = *(const unsigned*)(u + 256 + lane * 2);
    const bf16_t raw_kr = u[384 + (lane & 31)];
    const uint4 raw_sq = *(const uint4*)(u + 1968 + lane * 8);
    const uint4 raw_sk = *(const uint4*)(u + 2480 + (lane & 15) * 8);
    const uint4 raw_sv = *(const uint4*)(u + 2608 + (lane & 15) * 8);
    {
      float x0 = lo16(raw_q.x), x1 = hi16(raw_q.x), x2 = lo16(raw_q.y), x3 = hi16(raw_q.y);
      float ss = wave_sum(x0 * x0 + x1 * x1 + x2 * x2 + x3 * x3);
      float rs = rsqrtf(ss * (1.f / 256.f) + 1e-6f);
      float4 g = *(const float4*)(gq + lane * 4);
      *(uint2*)(u + lane * 4) = pack4(x0 * rs * g.x, x1 * rs * g.y, x2 * rs * g.z, x3 * rs * g.w);
    }
    {
      float x0 = lo16(raw_kv), x1 = hi16(raw_kv);
      float ss = wave_sum(x0 * x0 + x1 * x1);
      float rs = rsqrtf(ss * (1.f / 128.f) + 1e-6f);
      float c0 = x0 * rs * gkv[lane * 2], c1 = x1 * rs * gkv[lane * 2 + 1];
      *(unsigned*)(ckv + (size_t)key * 128 + lane * 2) = pack2(c0, c1);
      if (!G.sample) *(float2*)(p.out + O_CKV + orow * 128 + lane * 2) = make_float2(c0, c1);
    }
    if (lane < 32) {
      float x = bf2f(raw_kr);
      krope[(size_t)key * 32 + lane] = x;
      if (!G.sample) p.out[O_KROPE + orow * 32 + lane] = x;
    }
    float pr = (float)(pos >> 6), pc = (float)(pos & 63);
    {
      float x[8];
      unpack8(raw_sq, x);
      norm_rope64(x, gsq, lane & 7, G.sample != 0, pr, pc);
      *(uint4*)(Qs + (size_t)t * 512 + lane * 8) = pack8(x);
    }
    {
      float x[8];
      unpack8(raw_sk, x);
      norm_rope64(x, gsk, lane & 7, G.sample != 0, pr, pc);
      if (lane < 16) {
        *(uint4*)(Ks + (size_t)key * 128 + lane * 8) = pack8(x);
        if (!G.sample) {
          float* o = p.out + O_SWAK + orow * 128 + lane * 8;
          *(float4*)o = make_float4(x[0], x[1], x[2], x[3]);
          *(float4*)(o + 4) = make_float4(x[4], x[5], x[6], x[7]);
        }
        float vv[8];
        unpack8(raw_sv, vv);
        int kvh = lane >> 3, d0 = (lane & 7) * 8;
#pragma unroll
        for (int e = 0; e < 8; e++) Vts[((size_t)(sq * 2 + kvh) * 64 + d0 + e) * G.KS + pos] = f2bf(vv[e]);
        if (!G.sample) {
          float* o = p.out + O_SWAV + orow * 128 + lane * 8;
          *(float4*)o = make_float4(vv[0], vv[1], vv[2], vv[3]);
          *(float4*)(o + 4) = make_float4(vv[4], vv[5], vv[6], vv[7]);
        }
      }
    }
  }
  if (G.sample) {
    for (int r = bid * 4 + wv; r < G.NS * 256; r += nblk * 4) {
      int sq = r >> 8, c = r & 255, b = G.batch0 + sq;
      size_t key = (size_t)sq * G.KS + G.S + c;
      size_t srow = (size_t)(b * 2 + l) * 256 + c;
      float2 a = *(const float2*)(p.in[3] + srow * 128 + lane * 2);
      *(unsigned*)(ckv + key * 128 + lane * 2) = pack2(a.x, a.y);
      if (lane < 32) krope[key * 32 + lane] = p.in[4][srow * 32 + lane];
      float2 kk = *(const float2*)(p.in[5] + srow * 128 + lane * 2);
      *(unsigned*)(Ks + key * 128 + lane * 2) = pack2(kk.x, kk.y);
      float2 vv = *(const float2*)(p.in[6] + srow * 128 + lane * 2);
      int idx = lane * 2, kvh = idx >> 6, d = idx & 63;
      Vts[((size_t)(sq * 2 + kvh) * 64 + d) * G.KS + G.S + c] = f2bf(vv.x);
      Vts[((size_t)(sq * 2 + kvh) * 64 + d + 1) * G.KS + G.S + c] = f2bf(vv.y);
    }
  }
}

DEVI void phase_gemm_small(const Params& p, int l, const Grp& G, int bid, int nblk, char* smem, int mode = 0) {
  const bf16_t* WT = (const bf16_t*)(p.ws + OFF_WT) + (size_t)l * WT_LAYER;
  bf16_t* U = (bf16_t*)(p.ws + OFF_U);
  bf16_t* Qb = (bf16_t*)(p.ws + OFF_Q);
  bf16_t* ckv = (bf16_t*)(p.ws + OFF_CKV);
  bf16_t* knope = (bf16_t*)(p.ws + OFF_KNOPE);
  bf16_t* Vt = (bf16_t*)(p.ws + OFF_VT);
  bf16_t* wa = (bf16_t*)(p.ws + OFF_WA);
  bf16_t* gb = (bf16_t*)(p.ws + OFF_G);
  const int KS = G.KS;
  const int tid_ = TIDX, lane = tid_ & 63, wave = tid_ >> 6, wm = wave >> 1, wn = wave & 1;
  const int t_kv = (G.NK / 128) * 8, t_q = (G.TG / 128) * 6, t_l = (G.TG / 128) * 4;
  const int total = t_kv + t_q + 5 * t_l;
  const int t_begin = (mode == 2) ? t_kv + t_q : 0, t_end = (mode == 1) ? t_kv + t_q : total;
  for (int t = t_begin + bid; t < t_end; t += nblk) {
    int job, tt = t;
    if (tt < t_kv) job = 0;
    else if ((tt -= t_kv) < t_q) job = 1;
    else { tt -= t_q; job = 2 + tt / t_l; tt = tt % t_l; }
    const bf16_t *A, *B;
    int lda, ldb, K, tn;
    if (job == 0) { A = ckv; lda = 128; B = WT + W_UKV; ldb = 128; K = 128; tn = 8; }
    else if (job == 1) { A = U; lda = DIN; B = WT + W_UQ; ldb = 256; K = 256; tn = 6; }
    else if (job < 4) { int d = job - 2; A = U + 4272 + d * 64; lda = DIN; B = WT + W_W2 + d * 32768; ldb = 64; K = 64; tn = 4; }
    else if (job < 6) { int d = job - 4; A = U + 4400 + d * 64; lda = DIN; B = WT + W_A2 + d * 32768; ldb = 64; K = 64; tn = 4; }
    else { A = U + 4528; lda = DIN; B = WT + W_G2; ldb = 128; K = 128; tn = 4; }
    const int m0 = (tt / tn) * 128, n0 = (tt % tn) * 128;
    f32x4 acc[4][4];
#pragma unroll
    for (int i = 0; i < 4; i++)
#pragma unroll
      for (int j = 0; j < 4; j++) acc[i][j] = (f32x4){0.f, 0.f, 0.f, 0.f};
    gemm_core<4>(acc, A + (size_t)m0 * lda, lda, B + (size_t)n0 * ldb, ldb, K, smem);
#pragma unroll
    for (int i = 0; i < 4; i++)
#pragma unroll
      for (int j = 0; j < 4; j++) {
        const int row = m0 + wm * 64 + i * 16 + (lane & 15), col = n0 + wn * 64 + j * 16 + (lane >> 4) * 4;
        f32x4 v = acc[i][j];
        if (job == 0) {
          int hh = col >> 7, cc = col & 127;
          if (cc < 64) *(uint2*)(knope + (size_t)row * 512 + hh * 64 + cc) = pack4(v[0], v[1], v[2], v[3]);
          else {
            int sq = row / KS, pos = row % KS;
#pragma unroll
            for (int e = 0; e < 4; e++) Vt[((size_t)(sq * 8 + hh) * 64 + cc - 64 + e) * KS + pos] = f2bf(v[e]);
          }
        } else if (job == 1) {
          *(uint2*)(Qb + (size_t)row * 768 + col) = pack4(v[0], v[1], v[2], v[3]);
        } else if (job < 6) {
          int d = (job - 2) & 1, isa = job >= 4;
          const float* b0 = (isa ? p.in[34] : p.in[32]) + (l * 2 + d) * 512 + col;
          float4 bb = *(const float4*)b0;
          *(uint2*)(wa + (size_t)row * 2048 + isa * 1024 + d * 512 + col) = pack4(v[0] + bb.x, v[1] + bb.y, v[2] + bb.z, v[3] + bb.w);
        } else {
          *(uint2*)(gb + (size_t)row * 512 + col) = pack4(v[0], v[1], v[2], v[3]);
        }
      }
  }
}

DEVI void rope_pair(float (&a)[8], float (&b)[8], float pos) {
#pragma unroll
  for (int e = 0; e < 8; e++) {
    float ang = pos * exp2f(-(float)e * 1.660964f);
    float c = __cosf(ang), s = __sinf(ang);
    float na = a[e] * c - b[e] * s, nb = b[e] * c + a[e] * s;
    a[e] = na; b[e] = nb;
  }
}
DEVI void phase_prepb(const Params& p, int l, const Grp& G, int bid, int nblk) {
  bf16_t* Qb = (bf16_t*)(p.ws + OFF_Q);
  const bf16_t* knope = (const bf16_t*)(p.ws + OFF_KNOPE);
  const float* krope = (const float*)(p.ws + OFF_KROPE);
  bf16_t* Kb = (bf16_t*)(p.ws + OFF_K);
  const float* gqn = p.in[21] + l * 96;
  const float* gkn = p.in[22] + l * 96;
  const int nq = G.TG * 8, nk = G.NK * 8, ntot = nq + nk;
  const int tid_ = TIDX, lane = tid_ & 63, wv = tid_ >> 6;
  const int j = lane & 15;
  const int stride = nblk * 16;
  for (int idx0 = (bid * 4 + wv) * 4 + (lane >> 4); idx0 < ntot; idx0 += 2 * stride) {
    float x[2][8];
    int rowv[2], hdv[2], posv[2];
    bool isqv[2], act[2];
#pragma unroll
    for (int u = 0; u < 2; u++) {
      int idx = idx0 + u * stride;
      act[u] = idx < ntot;
      if (!act[u]) idx = idx0;
      bool isq = idx < nq;
      int id = isq ? idx : idx - nq;
      int row = id >> 3, hd = id & 7;
      isqv[u] = isq; rowv[u] = row; hdv[u] = hd;
      posv[u] = isq ? (row % G.S) : (row % G.KS);
#pragma unroll
      for (int e = 0; e < 8; e++) x[u][e] = 0.f;
      if (isq) {
        if (j < 12) unpack8(*(const uint4*)(Qb + (size_t)row * 768 + hd * 96 + j * 8), x[u]);
      } else {
        if (j < 8) unpack8(*(const uint4*)(knope + (size_t)row * 512 + hd * 64 + j * 8), x[u]);
        else if (j < 12) {
          const float* kr = krope + (size_t)row * 32 + (j - 8) * 8;
          float4 a = *(const float4*)kr, b2 = *(const float4*)(kr + 4);
          x[u][0] = a.x; x[u][1] = a.y; x[u][2] = a.z; x[u][3] = a.w; x[u][4] = b2.x; x[u][5] = b2.y; x[u][6] = b2.z; x[u][7] = b2.w;
        }
      }
    }
#pragma unroll
    for (int u = 0; u < 2; u++) {
      const bool isq = isqv[u];
      const int pos = posv[u];
      const bool rope = G.sample && (isq || pos < G.S);
      const float* g = isq ? gqn : gkn;
      float ss = 0.f;
#pragma unroll
      for (int e = 0; e < 8; e++) ss += x[u][e] * x[u][e];
      ss = row16_sum(ss);
      float rs = rsqrtf(ss * (1.f / 96.f) + 1e-6f);
      const int jj = j < 12 ? j : 0;
#pragma unroll
      for (int e = 0; e < 8; e++) x[u][e] = x[u][e] * rs * g[jj * 8 + e];
      {
        int c = j - 8;
        float posf = (c < 2) ? (float)(pos >> 6) : (float)(pos & 63);
        bool second = (c & 1) != 0;
#pragma unroll
        for (int e = 0; e < 8; e++) {
          float other = __shfl_xor(x[u][e], 1);
          float ang = posf * exp2f(-(float)e * 1.660964f);
          float cs = __cosf(ang), sn = __sinf(ang);
          float r = second ? x[u][e] * cs + other * sn : x[u][e] * cs - other * sn;
          if (rope && j >= 8) x[u][e] = r;
        }
      }
      if (j < 12 && act[u]) {
        bf16_t* dst = (isq ? Qb : Kb) + (size_t)rowv[u] * 768 + hdv[u] * 96 + j * 8;
        *(uint4*)dst = pack8(x[u]);
      }
    }
  }
}

DEVI float row32_sum(float x) {
  x = row16_sum(x);
  float a = x, b2 = x;
  asm volatile("s_nop 1\n\tv_permlane16_swap_b32 %0, %1" : "+v"(a), "+v"(b2));
  return a + b2;
}
DEVI void rwkv_item(const Params& p, int l, const Grp& G, int it, char* smem) {
  const int tid = TIDX, lane = tid & 63, wv = tid >> 6;
  const int rg = it & 7, d = (it >> 3) & 1, hd = (it >> 4) & 7, sq = it >> 7;
  const int b = G.batch0 + sq;
  const int rloc = wv * 2 + (lane >> 5), row = rg * 8 + rloc, pq = lane & 31;
  const int S = G.S;
  const bf16_t* U = (const bf16_t*)(p.ws + OFF_U);
  const bf16_t* wa = (const bf16_t*)(p.ws + OFF_WA);
  float* yout = (float*)(p.ws + OFF_YRW) + (size_t)d * G.TG * 512;
  float S0 = 0.f, S1 = 0.f;
  const size_t sbase = ((((size_t)(b * 2 + l) * 2 + d) * 8 + hd) * 64 + row) * 64 + pq * 2;
  if (G.sample) { float2 s = *(const float2*)(p.in[10] + sbase); S0 = s.x; S1 = s.y; }
  float* buf = (float*)smem;
  float* vb = buf + 2 * 16 * 320;
  const int ts = tid >> 4, kq = tid & 15;
  const float4 kk4 = *(const float4*)(p.in[37] + l * 512 + hd * 64 + kq * 4);
  const float4 ka4 = *(const float4*)(p.in[38] + l * 512 + hd * 64 + kq * 4);
  struct RwRegs { unsigned rr0, rr1, rk0, rk1, rw0, rw1, ra0, ra1, rv; };
  RwRegs RA, RB;
  auto issue = [&](int c, RwRegs& R) {
    int i = c * 16 + ts, pos = d ? S - 1 - i : i;
    size_t t = (size_t)sq * S + pos;
    const bf16_t* u = U + t * DIN;
    const unsigned* q;
    q = (const unsigned*)(u + 2736 + hd * 64 + kq * 4); R.rr0 = q[0]; R.rr1 = q[1];
    q = (const unsigned*)(u + 3248 + hd * 64 + kq * 4); R.rk0 = q[0]; R.rk1 = q[1];
    R.rv = u[3760 + hd * 64 + rg * 8 + (kq & 7)];
    q = (const unsigned*)(wa + t * 2048 + d * 512 + hd * 64 + kq * 4); R.rw0 = q[0]; R.rw1 = q[1];
    q = (const unsigned*)(wa + t * 2048 + 1024 + d * 512 + hd * 64 + kq * 4); R.ra0 = q[0]; R.ra1 = q[1];
  };
  auto stage = [&](int nb, const RwRegs& R) {
    float k0 = lo16(R.rk0), k1 = hi16(R.rk0), k2 = lo16(R.rk1), k3 = hi16(R.rk1);
    float q0 = k0 * kk4.x, q1 = k1 * kk4.y, q2 = k2 * kk4.z, q3 = k3 * kk4.w;
    float ss = row16_sum(q0 * q0 + q1 * q1 + q2 * q2 + q3 * q3);
    float rs = rsqrtf(ss + 1e-12f);
    float4 kh = make_float4(q0 * rs, q1 * rs, q2 * rs, q3 * rs);
    float4 a = make_float4(sigm(lo16(R.ra0)), sigm(hi16(R.ra0)), sigm(lo16(R.ra1)), sigm(hi16(R.ra1)));
    float4 w = make_float4(__expf(-0.6065306597f * sigm(lo16(R.rw0))), __expf(-0.6065306597f * sigm(hi16(R.rw0))),
                           __expf(-0.6065306597f * sigm(lo16(R.rw1))), __expf(-0.6065306597f * sigm(hi16(R.rw1))));
    float4 kt = make_float4(k0 * (1.f + (a.x - 1.f) * ka4.x), k1 * (1.f + (a.y - 1.f) * ka4.y), k2 * (1.f + (a.z - 1.f) * ka4.z), k3 * (1.f + (a.w - 1.f) * ka4.w));
    float4 akh = make_float4(a.x * kh.x, a.y * kh.y, a.z * kh.z, a.w * kh.w);
    float4 r4 = make_float4(lo16(R.rr0), hi16(R.rr0), lo16(R.rr1), hi16(R.rr1));
    float* bp = buf + (nb * 16 + ts) * 320 + kq * 4;
    *(float4*)(bp) = kh; *(float4*)(bp + 64) = w; *(float4*)(bp + 128) = akh; *(float4*)(bp + 192) = kt; *(float4*)(bp + 256) = r4;
    if (kq < 8) vb[(nb * 16 + ts) * 8 + kq] = lo16(R.rv);
  };
  auto steps = [&](int c) {
    const int cb = c & 1;
    float yp[16];
    const float* bp0 = buf + (cb * 16) * 320 + pq * 2;
    const float* vp0 = vb + (cb * 16) * 8 + rloc;
    float2 kh = *(const float2*)(bp0), w2 = *(const float2*)(bp0 + 64), akh = *(const float2*)(bp0 + 128), kt = *(const float2*)(bp0 + 192), r2 = *(const float2*)(bp0 + 256);
    float vv = vp0[0];
#pragma unroll
    for (int s = 0; s < 16; s++) {
      float2 khn = kh, w2n = w2, akhn = akh, ktn = kt, r2n = r2; float vvn = vv;
      if (s < 15) {
        const float* bp = bp0 + (s + 1) * 320;
        khn = *(const float2*)(bp); w2n = *(const float2*)(bp + 64); akhn = *(const float2*)(bp + 128); ktn = *(const float2*)(bp + 192); r2n = *(const float2*)(bp + 256);
        vvn = vp0[(s + 1) * 8];
      }
      float sk = row32_sum(S0 * kh.x + S1 * kh.y);
      S0 = (S0 * w2.x + vv * kt.x) - sk * akh.x;
      S1 = (S1 * w2.y + vv * kt.y) - sk * akh.y;
      yp[s] = S0 * r2.x + S1 * r2.y;
      kh = khn; w2 = w2n; akh = akhn; kt = ktn; r2 = r2n; vv = vvn;
    }
    float t8[8], u4[4], v2[2];
#pragma unroll
    for (int j = 0; j < 8; j++) {
      float a = yp[j], b2 = yp[j + 8];
      asm volatile("s_nop 1\n\tv_permlane16_swap_b32 %0, %1\n\ts_nop 1" : "+v"(a), "+v"(b2));
      t8[j] = a + b2;
    }
    const int q = lane & 15;
#pragma unroll
    for (int j = 0; j < 4; j++) { float A = dpp_add<0x128>(t8[j]), B = dpp_add<0x128>(t8[j + 4]); u4[j] = (q & 8) ? B : A; }
#pragma unroll
    for (int j = 0; j < 2; j++) { float A = dpp_add<0x141>(u4[j]), B = dpp_add<0x141>(u4[j + 2]); v2[j] = (q & 4) ? B : A; }
    float wA = dpp_add<0x4E>(v2[0]), wB = dpp_add<0x4E>(v2[1]);
    float wsel = (q & 2) ? wB : wA;
    float yfin = dpp_add<0xB1>(wsel);
    if ((q & 1) == 0) {
      const int sidx = ((lane >> 4) & 1) * 8 + ((q >> 3) & 1) * 4 + ((q >> 2) & 1) * 2 + ((q >> 1) & 1);
      int i = c * 16 + sidx, pos = d ? S - 1 - i : i;
      yout[((size_t)sq * S + pos) * 512 + hd * 64 + row] = yfin;
    }
  };
  const int nch = S / 16;
  __syncthreads();
  issue(0, RA); stage(0, RA);
  issue(1, RB);
  __syncthreads();
  for (int c = 0; c < nch; c += 2) {
    if (c + 2 < nch) issue(c + 2, RA);
    steps(c);
    stage(1, RB);
    __syncthreads();
    if (c + 3 < nch) issue(c + 3, RB);
    steps(c + 1);
    if (c + 2 < nch) stage(0, RA);
    __syncthreads();
  }
  if (!G.sample) *(float2*)(p.out + O_RW + sbase) = make_float2(S0, S1);
}

DEVI void mlstm_item(const Params& p, int l, const Grp& G, int it, char* smem) {
  const int tid = TIDX, lane = tid & 63, wv = tid >> 6;
  const int d = it & 1, hh = (it >> 1) & 3, sq = it >> 3;
  const int b = G.batch0 + sq, S = G.S;
  const bf16_t* U = (const bf16_t*)(p.ws + OFF_U);
  const float* lif = (const float*)(p.ws + OFF_LIF);
  float* hml = (float*)(p.ws + OFF_HML) + (size_t)d * G.TG * 512;
  bf16_t* sQ = (bf16_t*)smem;
  bf16_t* sK = sQ + 64 * 72;
  bf16_t* sVt = sK + 64 * 72;
  bf16_t* sKw = sVt + 144 * 72;
  bf16_t* sW = sKw + 64 * 72;
  bf16_t* sCt = sW + 64 * 72;
  float* gbuf = (float*)(sCt + 144 * 72);
  const size_t base = (((size_t)(b * 2 + l) * 2 + d) * 4 + hh);
  f32x4 ct[9];
  float m = 0.f;
  const int dcol0 = 16 * wv + (lane >> 4) * 4;
#pragma unroll
  for (int mt = 0; mt < 9; mt++) ct[mt] = (f32x4){0.f, 0.f, 0.f, 0.f};
  if (G.sample) {
    m = p.in[9][base];
#pragma unroll
    for (int mt = 0; mt < 8; mt++)
#pragma unroll
      for (int e = 0; e < 4; e++) ct[mt][e] = p.in[7][base * 8192 + (size_t)(dcol0 + e) * 128 + mt * 16 + (lane & 15)];
    if ((lane & 15) == 0)
#pragma unroll
      for (int e = 0; e < 4; e++) ct[8][e] = p.in[8][base * 64 + dcol0 + e];
  }
  u32x4 rq[2], rk[2], rvv[4];
  float liv = 0.f, lfv = 0.f;
  auto gload = [&](int c) {
#pragma unroll
    for (int i = 0; i < 2; i++) {
      int id = tid + i * 256, r = id >> 3, ck = id & 7;
      int ii = c * 64 + r, pos = d ? S - 1 - ii : ii;
      const bf16_t* u = U + ((size_t)sq * S + pos) * DIN;
      rq[i] = *(const u32x4*)(u + 416 + hh * 64 + ck * 8);
      rk[i] = *(const u32x4*)(u + 672 + hh * 64 + ck * 8);
    }
#pragma unroll
    for (int i = 0; i < 4; i++) {
      int id = tid + i * 256, r = id >> 4, ck = id & 15;
      int ii = c * 64 + r, pos = d ? S - 1 - ii : ii;
      rvv[i] = *(const u32x4*)(U + ((size_t)sq * S + pos) * DIN + 928 + hh * 128 + ck * 8);
    }
    if (wv == 0) {
      int ii = c * 64 + lane, pos = d ? S - 1 - ii : ii;
      size_t t = (size_t)sq * S + pos;
      liv = lif[t * 16 + d * 4 + hh]; lfv = lif[t * 16 + 8 + d * 4 + hh];
    }
  };
  auto gscan = [&](int c) {
    float bs = lfv;
#pragma unroll
    for (int o = 1; o < 64; o <<= 1) { float n = __shfl_up(bs, o); if (lane >= o) bs += n; }
    float u = liv - bs, pm = u;
#pragma unroll
    for (int o = 1; o < 64; o <<= 1) { float n = __shfl_up(pm, o); if (lane >= o) pm = fmaxf(pm, n); }
    float bL = __shfl(bs, 63);
    float gm = bL + u;
#pragma unroll
    for (int o = 32; o > 0; o >>= 1) gm = fmaxf(gm, __shfl_xor(gm, o));
    float* gb = gbuf + (c & 1) * 200;
    gb[lane] = bs; gb[64 + lane] = u; gb[128 + lane] = pm;
    if (lane == 0) { gb[192] = bL; gb[193] = gm; }
  };
  __syncthreads();
  for (int i = tid; i < 16 * 64; i += NTHREADS) { int r = i >> 6, c = i & 63; sVt[(128 + r) * 72 + c] = (r == 0) ? (bf16_t)0x3F80 : (bf16_t)0; }
#pragma unroll
  for (int mt = 0; mt < 9; mt++) *(uint2*)(sCt + (mt * 16 + (lane & 15)) * 72 + dcol0) = pack4(ct[mt][0], ct[mt][1], ct[mt][2], ct[mt][3]);
  gload(0);
  if (wv == 0) gscan(0);
  const int nch = S / 64;
  for (int c = 0; c < nch; c++) {
    __syncthreads();
#pragma unroll
    for (int i = 0; i < 2; i++) {
      int id = tid + i * 256, r = id >> 3, ck = id & 7;
      *(u32x4*)(sQ + r * 72 + ck * 8) = rq[i];
      *(u32x4*)(sK + r * 72 + ck * 8) = rk[i];
    }
#pragma unroll
    for (int i = 0; i < 4; i++) {
      int id = tid + i * 256, r = id >> 4, ck = id & 15;
      u32x4 raw = rvv[i];
      bf16_t* dst = sVt + (ck * 8) * 72 + r;
      dst[0] = (bf16_t)(raw.x & 0xffff); dst[72] = (bf16_t)(raw.x >> 16);
      dst[144] = (bf16_t)(raw.y & 0xffff); dst[216] = (bf16_t)(raw.y >> 16);
      dst[288] = (bf16_t)(raw.z & 0xffff); dst[360] = (bf16_t)(raw.z >> 16);
      dst[432] = (bf16_t)(raw.w & 0xffff); dst[504] = (bf16_t)(raw.w >> 16);
    }
    if (c + 1 < nch) gload(c + 1);
    __syncthreads();
    const float* gb = gbuf + (c & 1) * 200;
    const float bL = gb[192], gmax = gb[193];
    const float mnew = fmaxf(bL + m, gmax);
    const float decay = __expf(bL + m - mnew);
#pragma unroll
    for (int i = 0; i < 2; i++) {
      int id = tid + i * 256, r = id >> 3, ck = id & 7;
      float x[8];
      unpack8(*(const uint4*)(sK + r * 72 + ck * 8), x);
      float wk = __expf(bL + gb[64 + r] - mnew);
#pragma unroll
      for (int e = 0; e < 8; e++) sKw[(ck * 8 + e) * 72 + r] = f2bf(wk * x[e]);
    }
    const int trow = 16 * wv + (lane & 15);
    const float bt = gb[trow];
    const float mtt = bt + fmaxf(m, gb[128 + trow]);
    const float ain = __expf(bt + m - mtt);
    {
      f32x4 s4[4];
#pragma unroll
      for (int nt = 0; nt < 4; nt++) s4[nt] = (f32x4){0.f, 0.f, 0.f, 0.f};
#pragma unroll 1
      for (int kk = 0; kk < 2; kk++) {
        bf16x8 a = ldfrag_l(sQ, 72, 16 * wv, kk * 32, lane);
#pragma unroll
        for (int nt = 0; nt < 4; nt++) s4[nt] = mma(a, ldfrag_l(sK, 72, nt * 16, kk * 32, lane), s4[nt]);
      }
#pragma unroll
      for (int nt = 0; nt < 4; nt++) {
        float wv4[4];
#pragma unroll
        for (int e = 0; e < 4; e++) {
          int s = nt * 16 + (lane >> 4) * 4 + e;
          wv4[e] = (s <= trow) ? s4[nt][e] * __expf(bt + gb[64 + s] - mtt) : 0.f;
        }
        *(uint2*)(sW + trow * 72 + nt * 16 + (lane >> 4) * 4) = pack4(wv4[0], wv4[1], wv4[2], wv4[3]);
      }
    }
    __syncthreads();
    {
      f32x4 n1[9];
#pragma unroll
      for (int nt = 0; nt < 9; nt++) n1[nt] = (f32x4){0.f, 0.f, 0.f, 0.f};
#pragma unroll 1
      for (int kk = 0; kk < 2; kk++) {
        bf16x8 aQ = ldfrag_l(sQ, 72, 16 * wv, kk * 32, lane);
#pragma unroll
        for (int nt = 0; nt < 9; nt++) n1[nt] = mma(aQ, ldfrag_l(sCt, 72, nt * 16, kk * 32, lane), n1[nt]);
      }
#pragma unroll
      for (int nt = 0; nt < 9; nt++) n1[nt] *= ain;
#pragma unroll 1
      for (int kk = 0; kk < 2; kk++) {
        bf16x8 aW = ldfrag_l(sW, 72, 16 * wv, kk * 32, lane);
#pragma unroll
        for (int nt = 0; nt < 9; nt++) n1[nt] = mma(aW, ldfrag_l(sVt, 72, nt * 16, kk * 32, lane), n1[nt]);
      }
      float den = __shfl(n1[8][0], lane & 15);
      float inv = 1.f / fmaxf(fabsf(den), __expf(-mtt));
      int ii = c * 64 + trow, pos = d ? S - 1 - ii : ii;
      float* ho = hml + ((size_t)sq * S + pos) * 512 + hh * 128 + (lane >> 4) * 4;
#pragma unroll
      for (int nt = 0; nt < 8; nt++) *(float4*)(ho + nt * 16) = make_float4(n1[nt][0] * inv, n1[nt][1] * inv, n1[nt][2] * inv, n1[nt][3] * inv);
    }
#pragma unroll
    for (int mt = 0; mt < 9; mt++) ct[mt] *= decay;
#pragma unroll 1
    for (int kk = 0; kk < 2; kk++) {
      bf16x8 bk = ldfrag_l(sKw, 72, 16 * wv, kk * 32, lane);
#pragma unroll
      for (int mt = 0; mt < 9; mt++) ct[mt] = mma(ldfrag_l(sVt, 72, mt * 16, kk * 32, lane), bk, ct[mt]);
    }
    mfma_settle9(ct);
    __syncthreads();
#pragma unroll
    for (int mt = 0; mt < 9; mt++) *(uint2*)(sCt + (mt * 16 + (lane & 15)) * 72 + dcol0) = pack4(ct[mt][0], ct[mt][1], ct[mt][2], ct[mt][3]);
    if (wv == 0 && c + 1 < nch) gscan(c + 1);
    m = mnew;
  }
  if (!G.sample) {
#pragma unroll
    for (int mt = 0; mt < 8; mt++)
#pragma unroll
      for (int e = 0; e < 4; e++) p.out[O_MLC + base * 8192 + (size_t)(dcol0 + e) * 128 + mt * 16 + (lane & 15)] = ct[mt][e];
    if ((lane & 15) == 0)
#pragma unroll
      for (int e = 0; e < 4; e++) p.out[O_MLN + base * 64 + dcol0 + e] = ct[8][e];
    if (tid == 0) p.out[O_MLM + base] = m;
  }
}

template <int DQK, int DV, bool MASKED>
DEVI void attn_tile(const bf16_t* Qp, int ldq, const bf16_t* Kp, int ldk, const bf16_t* Vp, int KS, bf16_t* Yp, int ldy,
                    int q0, int S, int CTX, int W, bool has_sink, float sink, float scale, char* smem) {
  constexpr int KSTR = DQK + 8, NKK = DQK / 32, NDT = DV / 16;
  constexpr int NKC = (64 * (DQK / 8)) / NTHREADS;
  constexpr int NVC = (DV * 8) / NTHREADS;
  const int tid = TIDX, lane = tid & 63, wv = tid >> 6;
  bf16_t* sK = (bf16_t*)smem;
  bf16_t* sV = sK + 64 * KSTR;
  bf16_t* sP = sV + DV * 72 + wv * 32 * 72;
  const float cs = scale * 1.44269504f;
  bf16x8 qf[2][NKK];
#pragma unroll
  for (int i = 0; i < 2; i++)
#pragma unroll
    for (int kk = 0; kk < NKK; kk++)
      qf[i][kk] = *(const bf16x8*)(Qp + (size_t)(q0 + wv * 32 + i * 16 + (lane & 15)) * ldq + kk * 32 + (lane >> 4) * 8);
  f32x4 o[2][NDT];
  float mrow[2], lrow[2];
#pragma unroll
  for (int i = 0; i < 2; i++) {
#pragma unroll
    for (int dt = 0; dt < NDT; dt++) o[i][dt] = (f32x4){0.f, 0.f, 0.f, 0.f};
    mrow[i] = has_sink ? sink * 1.44269504f : -1e30f;
    lrow[i] = (has_sink && (lane >> 4) == 0) ? 1.f : 0.f;
  }
  int lo = q0 - W; if (lo < 0) lo = 0; lo &= ~63;
  int hi = q0 + 128 + W; if (hi > S) hi = S; hi = (hi + 63) & ~63;
  const int n1 = (hi - lo) / 64, n2 = CTX / 64, ntile = n1 + n2;
  u32x4 rk[NKC], rv[NVC];
  auto gload = [&](int it) {
    const int k0 = it < n1 ? lo + it * 64 : S + (it - n1) * 64;
#pragma unroll
    for (int c = 0; c < NKC; c++) {
      int id = tid + c * NTHREADS, r = id / (DQK / 8), ck = id % (DQK / 8);
      rk[c] = *(const u32x4*)(Kp + (size_t)(k0 + r) * ldk + ck * 8);
    }
#pragma unroll
    for (int c = 0; c < NVC; c++) {
      int id = tid + c * NTHREADS, r = id >> 3, ck = id & 7;
      rv[c] = *(const u32x4*)(Vp + (size_t)r * KS + k0 + ck * 8);
    }
  };
  gload(0);
  for (int it = 0; it < ntile; it++) {
    const int k0 = it < n1 ? lo + it * 64 : S + (it - n1) * 64;
    __syncthreads();
#pragma unroll
    for (int c = 0; c < NKC; c++) {
      int id = tid + c * NTHREADS, r = id / (DQK / 8), ck = id % (DQK / 8);
      *(u32x4*)(sK + r * KSTR + ck * 8) = rk[c];
    }
#pragma unroll
    for (int c = 0; c < NVC; c++) {
      int id = tid + c * NTHREADS, r = id >> 3, ck = id & 7;
      *(u32x4*)(sV + r * 72 + ck * 8) = rv[c];
    }
    __syncthreads();
    if (it + 1 < ntile) gload(it + 1);
    f32x4 s[2][4];
#pragma unroll
    for (int i = 0; i < 2; i++)
#pragma unroll
      for (int nt = 0; nt < 4; nt++) s[i][nt] = (f32x4){0.f, 0.f, 0.f, 0.f};
#pragma unroll
    for (int kk = 0; kk < NKK; kk++)
#pragma unroll
      for (int nt = 0; nt < 4; nt++) {
        bf16x8 bk = ldfrag_l(sK, KSTR, nt * 16, kk * 32, lane);
#pragma unroll
        for (int i = 0; i < 2; i++) s[i][nt] = mma(qf[i][kk], bk, s[i][nt]);
      }
#pragma unroll
    for (int i = 0; i < 2; i++) {
      float mx = -1e30f;
      if (MASKED) {
        const int qpos = q0 + wv * 32 + i * 16 + (lane & 15);
#pragma unroll
        for (int nt = 0; nt < 4; nt++)
#pragma unroll
          for (int e = 0; e < 4; e++) {
            int kidx = k0 + nt * 16 + (lane >> 4) * 4 + e;
            int dd = qpos - kidx; dd = dd < 0 ? -dd : dd;
            bool valid = (kidx >= S) || (dd <= W);
            float v = valid ? s[i][nt][e] * cs : -1e30f;
            s[i][nt][e] = v;
            mx = fmaxf(mx, v);
          }
      } else {
#pragma unroll
        for (int nt = 0; nt < 4; nt++)
#pragma unroll
          for (int e = 0; e < 4; e++) mx = fmaxf(mx, s[i][nt][e]);
        mx *= cs;
      }
      mx = fmaxf(mx, __shfl_xor(mx, 16)); mx = fmaxf(mx, __shfl_xor(mx, 32));
      float mn = fmaxf(mrow[i], mx);
      float alpha = __builtin_amdgcn_exp2f(mrow[i] - mn);
      mrow[i] = mn;
      float ls = 0.f;
#pragma unroll
      for (int nt = 0; nt < 4; nt++) {
        float pv[4];
#pragma unroll
        for (int e = 0; e < 4; e++) {
          if (MASKED) pv[e] = (s[i][nt][e] > -1e29f) ? __builtin_amdgcn_exp2f(s[i][nt][e] - mn) : 0.f;
          else pv[e] = __builtin_amdgcn_exp2f(__builtin_fmaf(s[i][nt][e], cs, -mn));
          ls += pv[e];
        }
        *(uint2*)(sP + (i * 16 + (lane & 15)) * 72 + nt * 16 + (lane >> 4) * 4) = pack4(pv[0], pv[1], pv[2], pv[3]);
      }
      lrow[i] = lrow[i] * alpha + ls;
#pragma unroll
      for (int dt = 0; dt < NDT; dt++) o[i][dt] *= alpha;
    }
    __builtin_amdgcn_fence(__ATOMIC_RELEASE, "wavefront");
    __builtin_amdgcn_wave_barrier();
    __builtin_amdgcn_fence(__ATOMIC_ACQUIRE, "wavefront");
#pragma unroll
    for (int kk = 0; kk < 2; kk++)
#pragma unroll
      for (int dt = 0; dt < NDT; dt++) {
        bf16x8 bv = ldfrag_l(sV, 72, dt * 16, kk * 32, lane);
#pragma unroll
        for (int i = 0; i < 2; i++) o[i][dt] = mma(ldfrag_l(sP, 72, i * 16, kk * 32, lane), bv, o[i][dt]);
      }
  }
#pragma unroll
  for (int i = 0; i < 2; i++) {
    float lsum = lrow[i];
    lsum += __shfl_xor(lsum, 16); lsum += __shfl_xor(lsum, 32);
    float inv = 1.f / lsum;
    bf16_t* yo = Yp + (size_t)(q0 + wv * 32 + i * 16 + (lane & 15)) * ldy + (lane >> 4) * 4;
#pragma unroll
    for (int dt = 0; dt < NDT; dt++) *(uint2*)(yo + dt * 16) = pack4(o[i][dt][0] * inv, o[i][dt][1] * inv, o[i][dt][2] * inv, o[i][dt][3] * inv);
  }
}

DEVI void attn_queues(const Params& p, int l, const Grp& G, char* smem, int* s_item, int* ctr) {
  const int nqt = G.S / 128;
  const int n_x = 2 * G.NS * nqt;
  bf16_t* Y = (bf16_t*)(p.ws + OFF_Y);
  const int x0 = blockIdx.x & 7;
#ifndef ATTNREP
#define ATTNREP 1
#endif
  for (int pass = 0; pass < ATTNREP; pass++)
  for (int xs = 0; xs < 8; xs++) {
    const int x = (x0 + xs) & 7;
    for (;;) {
      __syncthreads();
      if (TIDX == 0) *s_item = atomicAdd(ctr + 1 + pass * 16 + x, 1);
      __syncthreads();
      int it = *s_item;
      if (it >= n_x) break;
      const bool mla = it < G.NS * nqt;
      if (!mla) it -= G.NS * nqt;
      const int sq = it / nqt, qt = it % nqt, hd = x;
      if (mla) {
        attn_tile<96, 64, false>((const bf16_t*)(p.ws + OFF_Q) + (size_t)sq * G.S * 768 + hd * 96, 768,
                          (const bf16_t*)(p.ws + OFF_K) + (size_t)sq * G.KS * 768 + hd * 96, 768,
                          (const bf16_t*)(p.ws + OFF_VT) + (size_t)(sq * 8 + hd) * 64 * G.KS, G.KS,
                          Y + (size_t)sq * G.S * 2048 + hd * 64, 2048, qt * 128, G.S, G.CTX, 1 << 29, false, 0.f, 0.10206207f, smem);
      } else {
        int kvh = hd >> 2;
        attn_tile<64, 64, true>((const bf16_t*)(p.ws + OFF_QS) + (size_t)sq * G.S * 512 + hd * 64, 512,
                          (const bf16_t*)(p.ws + OFF_KS) + (size_t)sq * G.KS * 128 + kvh * 64, 128,
                          (const bf16_t*)(p.ws + OFF_VTS) + (size_t)(sq * 2 + kvh) * 64 * G.KS, G.KS,
                          Y + (size_t)sq * G.S * 2048 + 1024 + hd * 64, 2048, qt * 128, G.S, G.CTX, G.sample ? 128 : (1 << 29), true,
                          p.in[30][l * 8 + hd], 0.125f, smem);
      }
    }
  }
}

DEVI void chain_item(const Params& p, int l, const Grp& G, int it, int n_rw, char* smem) {
  if (it < n_rw) { __builtin_amdgcn_s_setprio(3); rwkv_item(p, l, G, it, smem); __builtin_amdgcn_s_setprio(0); }
  else { __builtin_amdgcn_s_setprio(2); mlstm_item(p, l, G, it - n_rw, smem); __builtin_amdgcn_s_setprio(0); }
}

DEVI void phase_mix(const Params& p, int l, int g, const Grp& G, char* smem, int* s_item, int coff) {
  int* ctr = (int*)(p.ws + OFF_CTR2) + ((coff ? 10 : 0) + l * 5 + g) * 32;
  const int n_rw = G.NS * 128, n_ml = G.NS * 8;
  const int n_chain = n_rw + n_ml;
  for (;;) {
    __syncthreads();
    if (TIDX == 0) *s_item = atomicAdd(ctr, 1);
    __syncthreads();
    int it = *s_item;
    if (it >= n_chain) break;
    chain_item(p, l, G, it, n_rw, smem);
  }
  attn_queues(p, l, G, smem, s_item, ctr);
}

DEVI void phase_post(const Params& p, int l, const Grp& G, int bid, int nblk) {
  const bf16_t* U = (const bf16_t*)(p.ws + OFF_U);
  const bf16_t* wa = (const bf16_t*)(p.ws + OFF_WA);
  const bf16_t* gb = (const bf16_t*)(p.ws + OFF_G);
  const float* hml = (const float*)(p.ws + OFF_HML);
  const float* yrw = (const float*)(p.ws + OFF_YRW);
  bf16_t* Y = (bf16_t*)(p.ws + OFF_Y);
  const int tid_ = TIDX, lane = tid_ & 63, wv = tid_ >> 6;
  const int c8 = lane * 8;
  const size_t dstr = (size_t)G.TG * 512;
  for (int t = bid * 4 + wv; t < G.TG; t += nblk * 4) {
    const bf16_t* u = U + (size_t)t * DIN;
    {
      const float* a = hml + (size_t)t * 512 + c8;
      float x[8];
      float4 f0 = *(const float4*)a, f1 = *(const float4*)(a + 4), b0 = *(const float4*)(a + dstr), b1 = *(const float4*)(a + dstr + 4);
      x[0] = f0.x + b0.x; x[1] = f0.y + b0.y; x[2] = f0.z + b0.z; x[3] = f0.w + b0.w;
      x[4] = f1.x + b1.x; x[5] = f1.y + b1.y; x[6] = f1.z + b1.z; x[7] = f1.w + b1.w;
      float ss = 0.f;
#pragma unroll
      for (int e = 0; e < 8; e++) ss += x[e] * x[e];
      ss += __shfl_xor(ss, 1); ss += __shfl_xor(ss, 2); ss += __shfl_xor(ss, 4); ss += __shfl_xor(ss, 8);
      float rs = rsqrtf(ss * (1.f / 128.f) + 1e-6f);
      const float* g = p.in[26] + l * 128 + (c8 & 127);
      float so[8];
      unpack8(*(const uint4*)(u + 1456 + c8), so);
#pragma unroll
      for (int e = 0; e < 8; e++) x[e] = x[e] * rs * g[e] * so[e];
      *(uint4*)(Y + (size_t)t * 2048 + 512 + c8) = pack8(x);
    }
    {
      const float* a = yrw + (size_t)t * 512 + c8;
      float y[8];
      float4 f0 = *(const float4*)a, f1 = *(const float4*)(a + 4), b0 = *(const float4*)(a + dstr), b1 = *(const float4*)(a + dstr + 4);
      y[0] = f0.x + b0.x; y[1] = f0.y + b0.y; y[2] = f0.z + b0.z; y[3] = f0.w + b0.w;
      y[4] = f1.x + b1.x; y[5] = f1.y + b1.y; y[6] = f1.z + b1.z; y[7] = f1.w + b1.w;
      float sm = 0.f;
#pragma unroll
      for (int e = 0; e < 8; e++) sm += y[e];
      sm += __shfl_xor(sm, 1); sm += __shfl_xor(sm, 2); sm += __shfl_xor(sm, 4);
      float mu = sm * (1.f / 64.f);
      float sv = 0.f;
#pragma unroll
      for (int e = 0; e < 8; e++) { y[e] -= mu; sv += y[e] * y[e]; }
      sv += __shfl_xor(sv, 1); sv += __shfl_xor(sv, 2); sv += __shfl_xor(sv, 4);
      float rs = rsqrtf(sv * (1.f / 64.f) + 64e-5f);
      float r[8], k[8], v[8];
      unpack8(*(const uint4*)(u + 2736 + c8), r);
      unpack8(*(const uint4*)(u + 3248 + c8), k);
      unpack8(*(const uint4*)(u + 3760 + c8), v);
      const float* ka = p.in[38] + l * 512 + c8;
      float sd = 0.f;
#pragma unroll
      for (int d = 0; d < 2; d++) {
        float ap[8];
        unpack8(*(const uint4*)(wa + (size_t)t * 2048 + 1024 + d * 512 + c8), ap);
        const float* uu = p.in[39] + (l * 2 + d) * 512 + c8;
#pragma unroll
        for (int e = 0; e < 8; e++) {
          float a_ = sigm(ap[e]);
          sd += r[e] * k[e] * (1.f + (a_ - 1.f) * ka[e]) * uu[e];
        }
      }
      sd += __shfl_xor(sd, 1); sd += __shfl_xor(sd, 2); sd += __shfl_xor(sd, 4);
      float gg[8];
      unpack8(*(const uint4*)(gb + (size_t)t * 512 + c8), gg);
      const float* gng = p.in[40] + l * 512 + c8;
      const float* gnb = p.in[41] + l * 512 + c8;
      float o[8];
#pragma unroll
      for (int e = 0; e < 8; e++) o[e] = (y[e] * rs * gng[e] + gnb[e] + sd * v[e]) * gg[e];
      *(uint4*)(Y + (size_t)t * 2048 + 1536 + c8) = pack8(o);
    }
  }
}

DEVI void phase_merge(const Params& p, int l, const Grp& G, int bid, int nblk, char* smem) {
  const bf16_t* WT = (const bf16_t*)(p.ws + OFF_WT) + (size_t)l * WT_LAYER;
  const bf16_t* U = (const bf16_t*)(p.ws + OFF_U);
  const bf16_t* Y = (const bf16_t*)(p.ws + OFF_Y);
  bf16_t* MG = (bf16_t*)(p.ws + OFF_MERGED);
  const int tid_ = TIDX, lane = tid_ & 63, wave = tid_ >> 6, wm = wave >> 1, wn = wave & 1;
  const int nt = (G.TG / 128) * 16;
  for (int t = bid; t < nt; t += nblk) {
    int m0 = (t >> 4) * 128, n0 = (t & 15) * 64;
    f32x4 tot[4][2];
#pragma unroll
    for (int i = 0; i < 4; i++)
#pragma unroll
      for (int j = 0; j < 2; j++) tot[i][j] = (f32x4){0.f, 0.f, 0.f, 0.f};
#pragma unroll 1
    for (int bch = 0; bch < 4; bch++) {
      f32x4 acc[4][2];
#pragma unroll
      for (int i = 0; i < 4; i++)
#pragma unroll
        for (int j = 0; j < 2; j++) acc[i][j] = (f32x4){0.f, 0.f, 0.f, 0.f};
      gemm_core<2>(acc, Y + (size_t)m0 * 2048 + bch * 512, 2048, WT + W_OA + (size_t)bch * 524288 + (size_t)n0 * 512, 512, 512, smem);
#pragma unroll
      for (int i = 0; i < 4; i++)
#pragma unroll
        for (int j = 0; j < 2; j++) {
          int row = m0 + wm * 64 + i * 16 + (lane & 15), col = n0 + wn * 32 + j * 16 + (lane >> 4) * 4;
          const unsigned* gp = (const unsigned*)(U + (size_t)row * DIN + 4656 + bch * 1024 + col);
          unsigned g0 = gp[0], g1 = gp[1];
          tot[i][j][0] += lo16(g0) * acc[i][j][0]; tot[i][j][1] += hi16(g0) * acc[i][j][1];
          tot[i][j][2] += lo16(g1) * acc[i][j][2]; tot[i][j][3] += hi16(g1) * acc[i][j][3];
        }
    }
#pragma unroll
    for (int i = 0; i < 4; i++)
#pragma unroll
      for (int j = 0; j < 2; j++) {
        int row = m0 + wm * 64 + i * 16 + (lane & 15), col = n0 + wn * 32 + j * 16 + (lane >> 4) * 4;
        *(uint2*)(MG + (size_t)row * 1024 + col) = pack4(tot[i][j][0], tot[i][j][1], tot[i][j][2], tot[i][j][3]);
      }
  }
}

DEVI void phase_wout(const Params& p, int l, const Grp& G, int bid, int nblk, char* smem) {
  const bf16_t* WT = (const bf16_t*)(p.ws + OFF_WT) + (size_t)l * WT_LAYER;
  const bf16_t* MG = (const bf16_t*)(p.ws + OFF_MERGED);
  const float* mod = (const float*)(p.ws + OFF_MOD);
  int rot = 0;
  gemm_tiles(MG, 1024, WT + W_OUT, 1024, G.TG, 1024, 1024, rot, bid, nblk, smem, [&](int row, int col, f32x4 v) {
    int gt = G.tok0 + row;
    const float* x;
    if (l == 0) x = (gt < 4096) ? p.in[0] + (size_t)gt * 1024 : p.in[1] + (size_t)(gt - 4096) * 1024;
    else x = p.out + (size_t)gt * 1024;
    int j = G.sample ? 1 + G.batch0 + row / 4096 : 0;
    float4 g1 = *(const float4*)(mod + (size_t)(l * 9 + j) * 6144 + 2048 + col);
    float4 xv = *(const float4*)(x + col);
    *(float4*)(p.out + (size_t)gt * 1024 + col) = make_float4(xv.x + g1.x * v[0], xv.y + g1.y * v[1], xv.z + g1.z * v[2], xv.w + g1.w * v[3]);
  });
}
DEVI void phase_mlp1(const Params& p, int l, const Grp& G, int bid, int nblk, char* smem) {
  const bf16_t* WT = (const bf16_t*)(p.ws + OFF_WT) + (size_t)l * WT_LAYER;
  const bf16_t* H = (const bf16_t*)(p.ws + OFF_H);
  bf16_t* HID = (bf16_t*)(p.ws + OFF_U);
  int rot = 0;
  gemm_tiles(H, 1024, WT + W_M1, 1024, G.TG, 4096, 1024, rot, bid, nblk, smem, [&](int row, int col, f32x4 v) {
    float a = fmaxf(v[0], 0.f), b = fmaxf(v[1], 0.f), c = fmaxf(v[2], 0.f), d = fmaxf(v[3], 0.f);
    *(uint2*)(HID + (size_t)row * 4096 + col) = pack4(a * a, b * b, c * c, d * d);
  });
}
DEVI void phase_mlp2(const Params& p, int l, const Grp& G, int bid, int nblk, char* smem) {
  const bf16_t* WT = (const bf16_t*)(p.ws + OFF_WT) + (size_t)l * WT_LAYER;
  const bf16_t* HID = (const bf16_t*)(p.ws + OFF_U);
  const float* mod = (const float*)(p.ws + OFF_MOD);
  int rot = 0;
  gemm_tiles(HID, 4096, WT + W_M2, 4096, G.TG, 1024, 4096, rot, bid, nblk, smem, [&](int row, int col, f32x4 v) {
    int gt = G.tok0 + row;
    int j = G.sample ? 1 + G.batch0 + row / 4096 : 0;
    float4 g2 = *(const float4*)(mod + (size_t)(l * 9 + j) * 6144 + 5120 + col);
    float* x = p.out + (size_t)gt * 1024 + col;
    float4 xv = *(const float4*)x;
    *(float4*)x = make_float4(xv.x + g2.x * v[0], xv.y + g2.y * v[1], xv.z + g2.z * v[2], xv.w + g2.w * v[3]);
  });
}


#define XB_TMO      128
#define XB_XCNT(j)  (256  + 64 * (j))
#define XB_XSUB(j)  (1280 + 64 * (j))
#define XB_XGEN(j)  (2304 + 64 * (j))
#define XB_TOP      3328
#define XB_TOPGEN   3392
#define XCD_BAR_WORDS 3456
#define XB_SPIN_CAP (1u << 22)
#define LAS __attribute__((address_space(3)))
DEVI unsigned xb_ld(unsigned* p) { return __hip_atomic_load(p, __ATOMIC_RELAXED, __HIP_MEMORY_SCOPE_AGENT); }
DEVI unsigned xb_add(unsigned* p, unsigned v) { return __hip_atomic_fetch_add(p, v, __ATOMIC_RELAXED, __HIP_MEMORY_SCOPE_AGENT); }
DEVI unsigned xb_xcc_id() { return (unsigned)__builtin_amdgcn_s_getreg((3 << 11) | 20) & 0xFu; }
#define XB_SPIN(cond, bar) do { unsigned _sp = 0; while (cond) { __builtin_amdgcn_s_sleep(1); \
    if ((++_sp & 255u) == 0u) { if (xb_ld(&(bar)[XB_TMO])) break; if (_sp > XB_SPIN_CAP) { atomicAdd(&(bar)[XB_TMO], 1u); break; } } } } while (0)
struct XcdBarrier { unsigned* bar; unsigned x; volatile LAS unsigned* st; };
DEVI XcdBarrier xcd_barrier_post(unsigned* bar, volatile LAS unsigned* st) {
  XcdBarrier b; b.bar = bar; b.x = xb_xcc_id(); b.st = st;
  if (__builtin_amdgcn_workitem_id_x() == 0) (void)xb_add(&bar[XB_XCNT(b.x)], 1u);
  return b;
}
DEVI void xcd_barrier_complete(unsigned* bar, unsigned x, unsigned& nloc, unsigned& nx) {
  const unsigned G = gridDim.x;
  unsigned sum, cnt, mine, sp = 0u;
  for (;;) {
    sum = 0u; cnt = 0u; mine = 0u;
#pragma unroll
    for (unsigned j = 0; j < 16; ++j) { const unsigned c = xb_ld(&bar[XB_XCNT(j)]); sum += c; cnt += (c > 0u) ? 1u : 0u; mine = (j == x) ? c : mine; }
    if (sum == G) break;
    __builtin_amdgcn_s_sleep(1);
    if ((++sp & 255u) == 0u) { if (xb_ld(&bar[XB_TMO])) break; if (sp > XB_SPIN_CAP) { atomicAdd(&bar[XB_TMO], 1u); break; } }
  }
  nloc = mine > 0u ? mine : 1u; nx = cnt > 0u ? cnt : 1u;
}
DEVI void xcd_barrier(const XcdBarrier& b) {
  asm volatile("s_waitcnt vmcnt(0)" ::: "memory");
  __syncthreads();
  if (__builtin_amdgcn_workitem_id_x() == 0) {
    unsigned* bar = b.bar;
    __builtin_amdgcn_s_waitcnt(0);
    unsigned nloc = b.st[0], nx = b.st[1];
    if (nloc == 0u) { xcd_barrier_complete(bar, b.x, nloc, nx); b.st[0] = nloc; b.st[1] = nx; }
    const unsigned old = xb_add(&bar[XB_XSUB(b.x)], 1u);
    const unsigned gen = old / nloc;
    if (old + 1u == (gen + 1u) * nloc) {
      __builtin_amdgcn_fence(__ATOMIC_RELEASE, "agent");
      asm volatile("s_waitcnt vmcnt(0)" ::: "memory");
      const unsigned og = xb_add(&bar[XB_TOP], 1u);
      const unsigned tg = og / nx;
      if (og + 1u == (tg + 1u) * nx) xb_add(&bar[XB_TOPGEN], 1u);
      else XB_SPIN(xb_ld(&bar[XB_TOPGEN]) == tg, bar);
      __builtin_amdgcn_fence(__ATOMIC_ACQUIRE, "agent");
      xb_add(&bar[XB_XGEN(b.x)], 1u);
      asm volatile("s_waitcnt vmcnt(0)" ::: "memory");
    } else {
      XB_SPIN(xb_ld(&bar[XB_XGEN(b.x)]) == gen, bar);
      __builtin_amdgcn_fence(__ATOMIC_ACQUIRE, "agent");
      asm volatile("s_waitcnt vmcnt(0)" ::: "memory");
    }
  }
  __syncthreads();
}

DEVI void flat_barrier(unsigned* cnt, unsigned target) {
  asm volatile("s_waitcnt vmcnt(0)" ::: "memory");
  __syncthreads();
  if (__builtin_amdgcn_workitem_id_x() == 0) {
    __builtin_amdgcn_fence(__ATOMIC_RELEASE, "agent");
    asm volatile("s_waitcnt vmcnt(0)" ::: "memory");
    xb_add(cnt, 1u);
    unsigned sp = 0;
    while (xb_ld(cnt) < target) { __builtin_amdgcn_s_sleep(1); if (++sp > (1u << 24)) break; }
    __builtin_amdgcn_fence(__ATOMIC_ACQUIRE, "agent");
    asm volatile("s_waitcnt vmcnt(0)" ::: "memory");
  }
  __syncthreads();
}

enum { PH_PRE = 0, PH_GEMM_IN, PH_PREPA, PH_GEMM_SMALL, PH_PREPB, PH_MIX, PH_POST, PH_MERGE, PH_WOUT, PH_PRE2, PH_MLP1, PH_MLP2, PH_COUNT };

DEVI void run_phase(const Params& p, int ph, int l, int g, int bid, int nblk, char* smem, int* s_item, int rep = 0) {
#ifndef SKIPMASK
#define SKIPMASK 0
#endif
#ifndef CASEMASK
#define CASEMASK 4095
#endif
  Grp G = get_grp(g);
  if ((SKIPMASK >> ph) & 1) return;
  switch (ph) {
    case PH_PRE: if (CASEMASK & 1) { phase_pre(p, l, G, 0, bid, nblk); } break;
    case PH_GEMM_IN: if (CASEMASK & 2) { phase_gemm_in(p, l, G, bid, nblk, smem); } break;
    case PH_PREPA: if (CASEMASK & 4) { phase_prepa(p, l, G, bid, nblk); } break;
    case PH_GEMM_SMALL: if (CASEMASK & 8) { phase_gemm_small(p, l, G, bid, nblk, smem); } break;
    case PH_PREPB: if (CASEMASK & 16) { phase_prepb(p, l, G, bid, nblk); } break;
    case PH_MIX: if (CASEMASK & 32) { phase_mix(p, l, g, G, smem, s_item, rep * 16); } break;
    case PH_POST: if (CASEMASK & 64) { phase_post(p, l, G, bid, nblk); } break;
    case PH_MERGE: if (CASEMASK & 128) { phase_merge(p, l, G, bid, nblk, smem); } break;
    case PH_WOUT: if (CASEMASK & 256) { phase_wout(p, l, G, bid, nblk, smem); } break;
    case PH_PRE2: if (CASEMASK & 512) { phase_pre(p, l, G, 1, bid, nblk); } break;
    case PH_MLP1: if (CASEMASK & 1024) { phase_mlp1(p, l, G, bid, nblk, smem); } break;
    case PH_MLP2: if (CASEMASK & 2048) { phase_mlp2(p, l, G, bid, nblk, smem); } break;
    default: break;
  }
}

#if MEGA
__global__ void __launch_bounds__(NTHREADS, 2) k_mega(Params p) {
  __shared__ __attribute__((aligned(16))) char smem[SMEM_BYTES];
  __shared__ int s_item;
  cg::grid_group grid = cg::this_grid();
  __shared__ uint4 xb_words;
  const int bid = blockIdx.x, nblk = gridDim.x;
  if (__builtin_amdgcn_workitem_id_x() == 0) xb_words = make_uint4(0u, 0u, 0u, 0u);
  phase_init(p, bid, nblk, smem);
  grid.sync();
  XcdBarrier xb = xcd_barrier_post((unsigned*)(p.ws + OFF_BAR), (volatile LAS unsigned*)&xb_words);
  unsigned* sb_cnt = (unsigned*)(p.ws + OFF_BAR) + 3520;
  unsigned sb_epoch = 0;
#pragma unroll 1
  for (int l = 0; l < 2; l++)
#pragma unroll 1
    for (int g = 0; g < 5; g++)
#pragma unroll 1
      for (int ph = 0; ph < PH_COUNT; ph++) {
        if (g > 0) {
          if (ph == PH_GEMM_SMALL || ph == PH_PREPB) continue;
          if (ph == PH_GEMM_IN) {
            Grp G = get_grp(g);
            phase_gemm_in(p, l, G, bid, nblk, smem, 1);
            xcd_barrier(xb);
            continue;
          }
          if (ph == PH_PREPA) {
            Grp G = get_grp(g);
            phase_prepa(p, l, G, bid, nblk);
            phase_gemm_small(p, l, G, bid, nblk, smem, 2);
            xcd_barrier(xb);
            continue;
          }
          if (ph == PH_MIX) {
            Grp G = get_grp(g);
            int* ctr = (int*)(p.ws + OFF_CTR2) + (l * 5 + g) * 32;
            const int n_rw = G.NS * 128, n_chain = n_rw + G.NS * 8;
            if (bid < n_chain) {
              chain_item(p, l, G, bid, n_rw, smem);
            } else {
              const int wid = bid - n_chain, nw = nblk - n_chain;
              phase_gemm_small(p, l, G, wid, nw, smem, 1);
              sb_epoch++; flat_barrier(sb_cnt, sb_epoch * (unsigned)nw);
              phase_prepb(p, l, G, wid, nw);
              sb_epoch++; flat_barrier(sb_cnt, sb_epoch * (unsigned)nw);
              if (__builtin_amdgcn_workitem_id_x() == 0) xb_add((unsigned*)ctr + 30, 1u);
            }
            if (bid >= n_rw && bid < n_chain) {
              if (__builtin_amdgcn_workitem_id_x() == 0) {
                unsigned sp = 0;
                while (xb_ld((unsigned*)ctr + 30) < (unsigned)(nblk - n_chain)) { __builtin_amdgcn_s_sleep(2); if (++sp > (1u << 24)) break; }
                __builtin_amdgcn_fence(__ATOMIC_ACQUIRE, "agent");
                asm volatile("s_waitcnt vmcnt(0)" ::: "memory");
              }
              __syncthreads();
            }
            if (bid >= n_rw) attn_queues(p, l, G, smem, &s_item, ctr);
            if (bid >= n_chain) phase_gemm_in(p, l, G, bid - n_chain, nblk - n_chain, smem, 2);
            xcd_barrier(xb);
            continue;
          }
        }
        run_phase(p, ph, l, g, bid, nblk, smem, &s_item);
        if (!(ph == PH_MLP2 && !(l == 1 && g == 4))) { xcd_barrier(xb); }
      }
}
#else
template <int PH>
__global__ void __launch_bounds__(NTHREADS, 2) k_phase(Params p, int l, int g) {
  __shared__ __attribute__((aligned(16))) char smem[SMEM_BYTES];
  __shared__ int s_item;
  const int bid = blockIdx.x, nblk = gridDim.x;
  if (PH < 0) phase_init(p, bid, nblk, smem);
  else run_phase(p, PH, l, g, bid, nblk, smem, &s_item);
}
template <int PH> void launch_phase(const Params& p, int l, int g, hipStream_t stream) {
  k_phase<PH><<<512, NTHREADS, 0, stream>>>(p, l, g);
}

#endif

extern "C" void kernel_launch(void* const* d_in, const int* in_sizes, int n_in, void* d_out, int out_size, void* d_ws, size_t ws_size,
                              hipStream_t stream) {
  Params p{};
  for (int i = 0; i < 46; i++) p.in[i] = (const float*)d_in[i];
  p.out = (float*)d_out;
  p.ws = (char*)d_ws;
  if (ws_size < WS_TOTAL) { fprintf(stderr, "workspace too small: %zu < %zu\n", ws_size, (size_t)WS_TOTAL); return; }
#if MEGA
  static int grid_blocks = 0;
  if (!grid_blocks) {
    int dev = 0, cus = 0, per_cu = 0;
    hipGetDevice(&dev);
    hipDeviceGetAttribute(&cus, hipDeviceAttributeMultiprocessorCount, dev);
    hipOccupancyMaxActiveBlocksPerMultiprocessor(&per_cu, k_mega, NTHREADS, 0);
    per_cu = 2;
    grid_blocks = cus * per_cu;
  }
  void* args[] = {&p};
  hipError_t e = hipLaunchCooperativeKernel((void*)k_mega, dim3(grid_blocks), dim3(NTHREADS), args, 0, stream);
  if (e != hipSuccess) fprintf(stderr, "cooperative launch failed: %s (grid %d)\n", hipGetErrorString(e), grid_blocks);
#else
  launch_phase<-1>(p, 0, 0, stream);
  for (int l = 0; l < 2; l++)
    for (int g = 0; g < 5; g++) {
      launch_phase<0>(p, l, g, stream); launch_phase<1>(p, l, g, stream); launch_phase<2>(p, l, g, stream); launch_phase<3>(p, l, g, stream);
      launch_phase<4>(p, l, g, stream); launch_phase<5>(p, l, g, stream); launch_phase<6>(p, l, g, stream); launch_phase<7>(p, l, g, stream);
      launch_phase<8>(p, l, g, stream); launch_phase<9>(p, l, g, stream); launch_phase<10>(p, l, g, stream); launch_phase<11>(p, l, g, stream);
    }
#endif
}
```
